# Optimizing an MI355X kernel written in HIP

```python
import math
import jax, jax.numpy as jnp
from jax import lax
import numpy as np

D_MODEL = 1024
BATCH = 4
SEQ = 4096
DEPTH = 2

N_MIXERS = 2
POOL_WINDOWS = (2, 4, 8, 16)
N_POOL_GROUPS = len(POOL_WINDOWS)
POOL_GROUP_W = D_MODEL // N_POOL_GROUPS
CONV_WIDTH = 3
D_FF = int(math.ceil(8 * D_MODEL / 3 / 256) * 256)
RMS_EPS = 1e-6
N_POOL_LAYERS = (DEPTH + 1) // 2
N_CONV_LAYERS = DEPTH // 2

kernel_name = "hybrid_pool_shortconv_sandwich"


def rms_norm(x, g):
    xf = x.astype(jnp.float32)
    y = xf * lax.rsqrt(jnp.mean(xf * xf, axis=-1, keepdims=True) + RMS_EPS)
    return (y * g.astype(jnp.float32)).astype(x.dtype)


def pool_mixer(h, w_groups, scale):
    bsz, seq, d = h.shape
    hg = h.astype(jnp.float32).reshape(bsz, seq, N_POOL_GROUPS, POOL_GROUP_W)
    cs = jnp.cumsum(hg, axis=1)
    pos = jnp.arange(1, seq + 1, dtype=jnp.float32)
    outs = []
    for g, w in enumerate(POOL_WINDOWS):
        c = cs[:, :, g]
        lagged = jnp.pad(c, ((0, 0), (w, 0), (0, 0)))[:, :seq]
        mean = (c - lagged) / jnp.minimum(pos, float(w))[None, :, None]
        outs.append(mean - hg[:, :, g])
    pooled = jnp.stack(outs, axis=2).astype(h.dtype)
    mixed = jnp.einsum('bsgc,gcd->bsgd', pooled, w_groups).reshape(bsz, seq, d)
    return mixed * scale


def short_conv_mixer(h, w_in, taps, w_out):
    seq = h.shape[1]
    proj = jnp.einsum('bsd,de->bse', h, w_in)
    b_gate, c_gate, v = jnp.split(proj, 3, axis=-1)
    u = c_gate * v
    up = jnp.pad(u, ((0, 0), (CONV_WIDTH - 1, 0), (0, 0)))
    conv = up[:, 0:seq] * taps[0]
    for k in range(1, CONV_WIDTH):
        conv = conv + up[:, k:k + seq] * taps[k]
    return jnp.einsum('bsd,de->bse', b_gate * conv, w_out)


def swiglu_ffn(h, w_gate_up, w_down):
    gu = jnp.einsum('bsd,df->bsf', h, w_gate_up)
    gate, up = jnp.split(gu, 2, axis=-1)
    return jnp.einsum('bsf,fd->bsd', jax.nn.silu(gate) * up, w_down)


def setup_inputs(seed: int = 0) -> dict:
    key = jax.random.key(seed)
    ks = jax.random.split(key, 10)
    f32 = jnp.float32
    x = jax.random.normal(ks[0], (BATCH, SEQ, D_MODEL), f32)
    norm_gains = 1.0 + 0.05 * jax.random.normal(ks[1], (DEPTH, 4, D_MODEL), f32)
    pool_w = jax.random.normal(ks[2], (N_POOL_LAYERS, N_POOL_GROUPS, POOL_GROUP_W, POOL_GROUP_W), f32) * POOL_GROUP_W ** -0.5
    pool_scale = 1.0 + 0.1 * jax.random.normal(ks[3], (N_POOL_LAYERS, D_MODEL), f32)
    conv_in_w = jax.random.normal(ks[4], (N_CONV_LAYERS, D_MODEL, 3 * D_MODEL), f32) * D_MODEL ** -0.5
    conv_w = jax.random.normal(ks[5], (N_CONV_LAYERS, CONV_WIDTH, D_MODEL), f32) * CONV_WIDTH ** -0.5
    conv_out_w = jax.random.normal(ks[6], (N_CONV_LAYERS, D_MODEL, D_MODEL), f32) * D_MODEL ** -0.5
    ffn_gate_up_w = jax.random.normal(ks[7], (DEPTH, D_MODEL, 2 * D_FF), f32) * D_MODEL ** -0.5
    ffn_down_w = jax.random.normal(ks[8], (DEPTH, D_FF, D_MODEL), f32) * D_FF ** -0.5
    return {"x": x, "norm_gains": norm_gains, "pool_w": pool_w, "pool_scale": pool_scale,
            "conv_in_w": conv_in_w, "conv_w": conv_w, "conv_out_w": conv_out_w,
            "ffn_gate_up_w": ffn_gate_up_w, "ffn_down_w": ffn_down_w}


def reference(x, norm_gains, pool_w, pool_scale, conv_in_w, conv_w, conv_out_w, ffn_gate_up_w, ffn_down_w):
    h = x
    for i in range(DEPTH):
        j = i // N_MIXERS
        g = norm_gains[i]
        hn = rms_norm(h, g[0])
        if i % N_MIXERS == 0:
            mix = pool_mixer(hn, pool_w[j], pool_scale[j])
        else:
            mix = short_conv_mixer(hn, conv_in_w[j], conv_w[j], conv_out_w[j])
        h = h + rms_norm(mix, g[1])
        ff = swiglu_ffn(rms_norm(h, g[2]), ffn_gate_up_w[i], ffn_down_w[i])
        h = h + rms_norm(ff, g[3])
    return h
```

```cpp
#include <hip/hip_runtime.h>
#include <hip/hip_cooperative_groups.h>
#include <cstdio>
#include <cstdint>
namespace cg = cooperative_groups;

#define LAS __attribute__((address_space(3)))
#define XB_TMO      128
#define XB_XCNT(j)  (256  + 64 * (j))
#define XB_XSUB(j)  (1280 + 64 * (j))
#define XB_XGEN(j)  (2304 + 64 * (j))
#define XB_TOP      3328
#define XB_TOPGEN   3392
#define XCD_BAR_WORDS 3456
#define XB_SPIN_CAP (1u << 18)

__device__ __forceinline__ unsigned xb_ld(unsigned* p)              { return __hip_atomic_load(p, __ATOMIC_RELAXED, __HIP_MEMORY_SCOPE_AGENT); }
__device__ __forceinline__ unsigned xb_add(unsigned* p, unsigned v) { return __hip_atomic_fetch_add(p, v, __ATOMIC_RELAXED, __HIP_MEMORY_SCOPE_AGENT); }
__device__ __forceinline__ unsigned xb_xcc_id() { return (unsigned)__builtin_amdgcn_s_getreg((3 << 11) | 20) & 0xFu; }
#define XB_SPIN(cond, bar) do { unsigned _sp = 0; while (cond) { __builtin_amdgcn_s_sleep(1); \
    if ((++_sp & 255u) == 0u) { if (xb_ld(&(bar)[XB_TMO])) break; if (_sp > XB_SPIN_CAP) { atomicAdd(&(bar)[XB_TMO], 1u); break; } } } } while (0)

struct XcdBarrier {
    unsigned* bar; unsigned x;
    volatile LAS unsigned* st;
};

__device__ __forceinline__ XcdBarrier xcd_barrier_post(unsigned* bar, volatile LAS unsigned* st) {
    XcdBarrier b; b.bar = bar; b.x = xb_xcc_id(); b.st = st;
    if (threadIdx.x == 0) (void)xb_add(&bar[XB_XCNT(b.x)], 1u);
    return b;
}
__device__ __forceinline__ void xcd_barrier_complete(unsigned* bar, unsigned x, unsigned& nloc, unsigned& nx) {
    const unsigned G = gridDim.x * gridDim.y * gridDim.z;
    unsigned sum, cnt, mine, sp = 0u;
    for (;;) {
        sum = 0u; cnt = 0u; mine = 0u;
#pragma unroll
        for (unsigned j = 0; j < 16; ++j) { const unsigned c = xb_ld(&bar[XB_XCNT(j)]); sum += c; cnt += (c > 0u) ? 1u : 0u; mine = (j == x) ? c : mine; }
        if (sum == G) break;
        __builtin_amdgcn_s_sleep(1);
        if ((++sp & 255u) == 0u) { if (xb_ld(&bar[XB_TMO])) break; if (sp > XB_SPIN_CAP) { atomicAdd(&bar[XB_TMO], 1u); break; } }
    }
    nloc = mine > 0u ? mine : 1u; nx = cnt > 0u ? cnt : 1u;
}

__device__ __forceinline__ void xcd_barrier(const XcdBarrier& b) {
    asm volatile("s_waitcnt vmcnt(0)" ::: "memory");
    __syncthreads();
    if (threadIdx.x == 0) {
        unsigned* bar = b.bar; unsigned bx = b.x; asm volatile("" : "+s"(bx));
        __builtin_amdgcn_s_waitcnt(0);
        unsigned nloc = b.st[0], nx = b.st[1];
        if (nloc == 0u) { xcd_barrier_complete(bar, bx, nloc, nx); b.st[0] = nloc; b.st[1] = nx; }
        const unsigned old = xb_add(&bar[XB_XSUB(bx)], 1u);
        const unsigned gen = old / nloc;
        if (old + 1u == (gen + 1u) * nloc) {
            __builtin_amdgcn_fence(__ATOMIC_RELEASE, "agent");
            asm volatile("s_waitcnt vmcnt(0)" ::: "memory");
            const unsigned og = xb_add(&bar[XB_TOP], 1u);
            const unsigned tg = og / nx;
            if (og + 1u == (tg + 1u) * nx) xb_add(&bar[XB_TOPGEN], 1u);
            else XB_SPIN(xb_ld(&bar[XB_TOPGEN]) == tg, bar);
            __builtin_amdgcn_fence(__ATOMIC_ACQUIRE, "agent");
            xb_add(&bar[XB_XGEN(bx)], 1u);
            asm volatile("s_waitcnt vmcnt(0)" ::: "memory");
        } else {
            XB_SPIN(xb_ld(&bar[XB_XGEN(bx)]) == gen, bar);
            __builtin_amdgcn_fence(__ATOMIC_ACQUIRE, "agent");
            asm volatile("s_waitcnt vmcnt(0)" ::: "memory");
        }
    }
    __syncthreads();
}
#ifndef PG8_WGM
#define PG8_WGM 8
#endif
namespace pg8 {
#define PG8_LAS __attribute__((address_space(3)))
typedef unsigned short bf16_t;
typedef short bf16x8 __attribute__((ext_vector_type(8)));
typedef float f32x4 __attribute__((ext_vector_type(4)));
typedef unsigned u32x4 __attribute__((ext_vector_type(4)));
constexpr int BM = 256, BK = 64, HALF = 128, HTB = HALF * BK * 2  , STAGE_BYTES = 8 * HTB, NXCD = 8, WGM = PG8_WGM;

__host__ __device__ __forceinline__ int lds_byte(int r, int c) { const int st = (r >> 4) * 2 + (c >> 5), rr = r & 15, cc = c & 31, ob = rr * 64 + cc * 2; return st * 1024 + (ob ^ (((ob >> 9) & 1) << 5)); }
__host__ __device__ __forceinline__ void stage_rc(int b, int& R, int& C) { const int st = b / 1024, sb = b % 1024, swz = sb ^ (((sb >> 9) & 1) << 5); R = (st >> 1) * 16 + swz / 64; C = (st & 1) * 32 + (swz % 64) / 2; }
__host__ __device__ __forceinline__ int perm32(int rho) { const int n = rho >> 4, i = rho & 15; return 8 * (i >> 2) + 4 * n + (i & 3); }

struct Unit { int pm, pn; };
struct Gemm { const bf16_t* A; const bf16_t* Bt; int M, N, K; };

struct StaticOrder {
    int nM, nN, nwg, G, c;
    __host__ __device__ void init(int M, int N, int G_, int c_) { nM = M / BM; nN = N / BM; nwg = nM * nN; G = G_; c = c_; }
    __host__ __device__ bool next(int i, Unit& u) const {
        const long L = (long)i * G + c; if (L >= nwg) return false;
        int wgid = (int)L; { const int q = nwg / NXCD, r = nwg % NXCD, xcd = wgid % NXCD, off = wgid / NXCD; wgid = (xcd < r ? xcd * (q + 1) : r * (q + 1) + (xcd - r) * q) + off; }
        const int nig = WGM * nN, gid = wgid / nig, fm = gid * WGM, gsz = (nM - fm) < WGM ? (nM - fm) : WGM;
        u.pm = fm + ((wgid % nig) % gsz); u.pn = (wgid % nig) / gsz; return true;
    }
    __device__ __forceinline__ void a_ready(const Unit&) const {}
    __device__ __forceinline__ void done(const Unit&) const {}
};

__device__ __forceinline__ unsigned cvt_pk_bf16(float lo, float hi) { unsigned r; asm volatile("v_cvt_pk_bf16_f32 %0, %1, %2" : "=v"(r) : "v"(lo), "v"(hi)); return r; }
__device__ __forceinline__ void glds16s(const void* sbase, unsigned voff, unsigned lds_dst) { unsigned keep;
    asm volatile("s_mov_b32 %0, m0\n\ts_mov_b32 m0, %3\n\ts_nop 0\n\tglobal_load_lds_dwordx4 %1, %2\n\ts_mov_b32 m0, %0" : "=&s"(keep) : "v"(voff), "s"(sbase), "s"(lds_dst) : "memory"); }
constexpr int MROWS = 16384, DM = 1024, DFF = 2816;
constexpr float RMS_EPS = 1e-6f;

__device__ __forceinline__ float rstd_of(const f32x4 p) { return rsqrtf(((p[0] + p[1]) + (p[2] + p[3])) * (1.0f / DM) + RMS_EPS); }
__device__ __forceinline__ float row_rstd4(const float* st, int row) { return rstd_of(*(const f32x4*)(st + (size_t)row * 4)); }
__device__ __forceinline__ unsigned cvt_pk(float lo, float hi) { unsigned r; asm("v_cvt_pk_bf16_f32 %0, %1, %2" : "=v"(r) : "v"(lo), "v"(hi)); return r; }
__device__ __forceinline__ void load_rs8(const float* st, int row0, float (&rs)[2][4]) {
    f32x4 p[2][4];
#pragma unroll
    for (int ai = 0; ai < 2; ++ai)
#pragma unroll
        for (int m = 0; m < 4; ++m) p[ai][m] = *(const f32x4*)(st + (size_t)(row0 + ai * HALF + m * 16) * 4);
#pragma unroll
    for (int ai = 0; ai < 2; ++ai)
#pragma unroll
        for (int m = 0; m < 4; ++m) rs[ai][m] = rstd_of(p[ai][m]);
}

__device__ __forceinline__ void table_rs8(PG8_LAS float* T, const f32x4 st, int tid, int lrow0, float (&rs)[2][4]) {
    if (tid < 256) T[tid] = rstd_of(st);
    asm volatile("s_waitcnt lgkmcnt(0)" ::: "memory"); __builtin_amdgcn_s_barrier(); asm volatile("" ::: "memory");
#pragma unroll
    for (int ai = 0; ai < 2; ++ai)
#pragma unroll
        for (int m = 0; m < 4; ++m) rs[ai][m] = T[lrow0 + ai * HALF + m * 16];
}

__device__ __forceinline__ float lane_xor(float v, int lane, int mask) { return __builtin_bit_cast(float, __builtin_amdgcn_ds_bpermute((lane ^ mask) << 2, __builtin_bit_cast(int, v))); }

struct EpiSwiGLU {
    static constexpr bool PERM = true, AFTER_DRAIN = false;
    bf16_t* O; const float* hstat; PG8_LAS float* T;
    struct Pre { f32x4 st; };
    __device__ __forceinline__ Pre prefetch(const Unit& u, int tid) const { Pre p; p.st = (f32x4){1.f, 1.f, 1.f, 1.f}; if (tid < 256) p.st = *(const f32x4*)((const char*)hstat + (unsigned)(u.pm * BM + tid) * 16u); return p; }
    __device__ __forceinline__ void operator()(const f32x4 (&acc)[2][2][4][2], const Unit& u, int wr, int wc, int fr, int fq, const Pre& pre, int tid) const {
        asm volatile("" : "+v"(fr));
        const int row0 = u.pm * BM + wr * 64 + fr, col0 = u.pn * 128 + wc * 32 + 8 * fq;
        const unsigned vo = (unsigned)(row0 * DFF + col0) * 2u; char* obase = (char*)O;
        float rsv[2][4]; table_rs8(T, pre.st, tid, wr * 64 + fr, rsv);
#pragma unroll
        for (int ai = 0; ai < 2; ++ai)
#pragma unroll
            for (int m = 0; m < 4; ++m) {
                const float rs = rsv[ai][m];
                f32x4 o[2];
#pragma unroll
                for (int n = 0; n < 2; ++n) {
                    const f32x4 g = acc[ai][0][m][n] * rs, up = acc[ai][1][m][n] * rs;
                    f32x4 e = g * (-1.4426950408889634f);
                    e[0] = __builtin_amdgcn_exp2f(e[0]); e[1] = __builtin_amdgcn_exp2f(e[1]); e[2] = __builtin_amdgcn_exp2f(e[2]); e[3] = __builtin_amdgcn_exp2f(e[3]);
                    e = e + 1.0f;
                    e[0] = __builtin_amdgcn_rcpf(e[0]); e[1] = __builtin_amdgcn_rcpf(e[1]); e[2] = __builtin_amdgcn_rcpf(e[2]); e[3] = __builtin_amdgcn_rcpf(e[3]);
                    o[n] = (g * e) * up;
                }
                u32x4 w; w.x = cvt_pk(o[0][0], o[0][1]); w.y = cvt_pk(o[0][2], o[0][3]); w.z = cvt_pk(o[1][0], o[1][1]); w.w = cvt_pk(o[1][2], o[1][3]);
                *(u32x4*)(obase + (vo + (unsigned)((ai * HALF + m * 16) * DFF * 2))) = w;
            }
    }
};

__device__ __forceinline__ float bfl(unsigned w) { return __builtin_bit_cast(float, w << 16); }
__device__ __forceinline__ float bfh(unsigned w) { return __builtin_bit_cast(float, w & 0xffff0000u); }
template <int CTRL> __device__ __forceinline__ u32x4 dpp_row_shr(u32x4 old, u32x4 src) {
    u32x4 r;
#pragma unroll
    for (int c = 0; c < 4; ++c) r[c] = (unsigned)__builtin_amdgcn_update_dpp((int)old[c], (int)src[c], CTRL, 0xf, 0xf, false);
    return r;
}
struct EpiInProj {
    static constexpr bool PERM = true, AFTER_DRAIN = false;
    bf16_t* Gb; bf16_t* Ub; bf16_t* Bs; const float* taps; const float* hstat; PG8_LAS float* T;
    struct Pre { f32x4 st; };
    __device__ __forceinline__ Pre prefetch(const Unit& u, int tid) const { Pre p; p.st = (f32x4){1.f, 1.f, 1.f, 1.f}; if (tid < 256) p.st = *(const f32x4*)((const char*)hstat + (unsigned)(u.pm * BM + tid) * 16u); return p; }
    __device__ __forceinline__ void operator()(const f32x4 (&acc)[2][2][4][2], const Unit& u, int wr, int wc, int fr, int fq, const Pre& pre, int tid) const {
        asm volatile("" : "+v"(fr));
        const int lrow0 = wr * 64 + fr, row0 = u.pm * BM + lrow0;
        float rsv[2][4]; table_rs8(T, pre.st, tid, lrow0, rsv);
        if (u.pn >= 4) {
            const int col0 = (u.pn - 4) * 128 + wc * 32 + 8 * fq;
            const unsigned vo = (unsigned)(row0 * DM + col0) * 2u; char* ub = (char*)Ub;
#pragma unroll
            for (int ai = 0; ai < 2; ++ai)
#pragma unroll
                for (int m = 0; m < 4; ++m) {
                    const float rs = rsv[ai][m];
                    const f32x4 v0 = (acc[ai][0][m][0] * rs) * (acc[ai][1][m][0] * rs), v1 = (acc[ai][0][m][1] * rs) * (acc[ai][1][m][1] * rs);
                    u32x4 w; w.x = cvt_pk(v0[0], v0[1]); w.y = cvt_pk(v0[2], v0[3]); w.z = cvt_pk(v1[0], v1[1]); w.w = cvt_pk(v1[2], v1[3]);
                    *(u32x4*)(ub + (vo + (unsigned)((ai * HALF + m * 16) * DM * 2))) = w;
                }
        } else {
            const bool side = (u.pm & 15) != 0;
            const char* ubase = (const char*)Ub; char* gbase = (char*)Gb;
#pragma unroll
            for (int bj = 0; bj < 2; ++bj) {
                const int cb = u.pn * 256 + bj * HALF + wc * 32 + 8 * fq;
                const unsigned vo = (unsigned)(row0 * DM + cb) * 2u;
                const f32x4 w0a = *(const f32x4*)(taps + cb), w0b = *(const f32x4*)(taps + cb + 4), w1a = *(const f32x4*)(taps + DM + cb), w1b = *(const f32x4*)(taps + DM + cb + 4),
                            w2a = *(const f32x4*)(taps + 2 * DM + cb), w2b = *(const f32x4*)(taps + 2 * DM + cb + 4);
#pragma unroll
                for (int aim = 0; aim < 4; ++aim) {
                    const int ai = aim >> 1, mb = (aim & 1) * 2;
                    u32x4 x0[4], x1[4], x2[4];
#pragma unroll
                    for (int m = mb; m < mb + 2; ++m) {
                        const unsigned o = vo + (unsigned)((ai * HALF + m * 16) * DM * 2);
                        unsigned o1 = (fr == 0) ? o - (unsigned)(DM * 2) : o, o2 = (fr < 2) ? o - (unsigned)(2 * DM * 2) : o;
                        if (ai == 0 && m == 0) { o1 = lrow0 >= 1 ? o1 : o; o2 = lrow0 >= 2 ? o2 : o; }
                        x0[m] = *(const u32x4*)(ubase + o); x1[m] = *(const u32x4*)(ubase + o1); x2[m] = *(const u32x4*)(ubase + o2);
                    }
#pragma unroll
                    for (int m = mb; m < mb + 2; ++m) {
                        const unsigned o = vo + (unsigned)((ai * HALF + m * 16) * DM * 2);
                        const float rs = rsv[ai][m];
                        const f32x4 ba = acc[ai][bj][m][0] * rs, bb = acc[ai][bj][m][1] * rs;
                        x1[m] = dpp_row_shr<0x111>(x1[m], x0[m]); x2[m] = dpp_row_shr<0x112>(x2[m], x0[m]);
                        f32x4 ua, ub_, ga, gb;
                        ua = (f32x4){bfl(x2[m][0]), bfh(x2[m][0]), bfl(x2[m][1]), bfh(x2[m][1])}; ub_ = (f32x4){bfl(x2[m][2]), bfh(x2[m][2]), bfl(x2[m][3]), bfh(x2[m][3])};
                        if (ai == 0 && m == 0) { const float k2 = lrow0 >= 2 ? 1.f : 0.f; ua = ua * k2; ub_ = ub_ * k2; }
                        ga = w0a * ua; gb = w0b * ub_;
                        ua = (f32x4){bfl(x1[m][0]), bfh(x1[m][0]), bfl(x1[m][1]), bfh(x1[m][1])}; ub_ = (f32x4){bfl(x1[m][2]), bfh(x1[m][2]), bfl(x1[m][3]), bfh(x1[m][3])};
                        if (ai == 0 && m == 0) { const float k1 = lrow0 >= 1 ? 1.f : 0.f; ua = ua * k1; ub_ = ub_ * k1; }
                        ga = ga + w1a * ua; gb = gb + w1b * ub_;
                        ua = (f32x4){bfl(x0[m][0]), bfh(x0[m][0]), bfl(x0[m][1]), bfh(x0[m][1])}; ub_ = (f32x4){bfl(x0[m][2]), bfh(x0[m][2]), bfl(x0[m][3]), bfh(x0[m][3])};
                        ga = (ga + w2a * ua) * ba; gb = (gb + w2b * ub_) * bb;
                        u32x4 w; w.x = cvt_pk(ga[0], ga[1]); w.y = cvt_pk(ga[2], ga[3]); w.z = cvt_pk(gb[0], gb[1]); w.w = cvt_pk(gb[2], gb[3]);
                        *(u32x4*)(gbase + o) = w;
                        if (ai == 0 && m == 0) { if (side && lrow0 < 2) { u32x4 q; q.x = cvt_pk(ba[0], ba[1]); q.y = cvt_pk(ba[2], ba[3]); q.z = cvt_pk(bb[0], bb[1]); q.w = cvt_pk(bb[2], bb[3]);
                            *(u32x4*)(Bs + (size_t)(u.pm * 2 + lrow0) * DM + cb) = q; } }
                    }
                    __builtin_amdgcn_sched_barrier(0);
                }
            }
        }
    }
};
struct TripleOrder {
    int c;
    __device__ bool next(int i, Unit& u) const {
        if (i > 2 || c >= 256) return false;
        const int xcd = c & 7, off = c >> 3, j = off >> 3; u.pm = xcd * 8 + (off & 7);
        u.pn = (i == 2) ? j : 4 + 2 * j + i; return true;
    }
    __device__ __forceinline__ void a_ready(const Unit&) const {}
    __device__ __forceinline__ void done(const Unit&) const {}
};

struct EpiSeam {
    static constexpr bool PERM = true, AFTER_DRAIN = true;
    struct Pre {};
    __device__ __forceinline__ Pre prefetch(const Unit&, int) const { return Pre{}; }
    const float* hin32; const bf16_t* hinb; float* hout32; bf16_t* houtb; const float* gpost; const float* colscale; float* ystat; float* hstat; unsigned* cnt;
    __device__ __forceinline__ void fused(f32x4 (&acc)[2][2][4][2], const Unit& u, int wr, int wc, int fr, int fq, PG8_LAS unsigned char* lds, int wid, int lane) const {
        PG8_LAS float* P = (PG8_LAS float*)lds;
        PG8_LAS float* R = (PG8_LAS float*)(lds + 4096);
        const int tid = wid * 64 + lane;
        const int rowbase = (u.pm & 63) * BM, colbase = u.pn * BM;
        const int lcol = colbase + wc * 32 + 8 * fq;
        if (colscale) {
#pragma unroll
            for (int bj = 0; bj < 2; ++bj)
#pragma unroll
                for (int n = 0; n < 2; ++n) {
                    const f32x4 sc = *(const f32x4*)(colscale + lcol + bj * HALF + 4 * n);
#pragma unroll
                    for (int ai = 0; ai < 2; ++ai)
#pragma unroll
                        for (int m = 0; m < 4; ++m) acc[ai][bj][m][n] = acc[ai][bj][m][n] * sc;
                }
        }
#pragma unroll
        for (int ai = 0; ai < 2; ++ai)
#pragma unroll
            for (int m = 0; m < 4; ++m) {
                float s = 0.f;
#pragma unroll
                for (int bj = 0; bj < 2; ++bj)
#pragma unroll
                    for (int n = 0; n < 2; ++n) { const f32x4 x = acc[ai][bj][m][n]; s += (x[0] * x[0] + x[1] * x[1]) + (x[2] * x[2] + x[3] * x[3]); }
                s += lane_xor(s, lane, 16); s += lane_xor(s, lane, 32);
                if (fq == 0) P[(ai * HALF + wr * 64 + m * 16 + fr) * 4 + wc] = s;
            }
        __syncthreads();
        f32x4 gp[2][2];
#pragma unroll
        for (int bj = 0; bj < 2; ++bj)
#pragma unroll
            for (int n = 0; n < 2; ++n) gp[bj][n] = *(const f32x4*)(gpost + lcol + bj * HALF + 4 * n);
        constexpr int YP = 260;
        PG8_LAS float* Y = (PG8_LAS float*)(lds + 8192);
#define SEAM_STAGE(ai_) do { _Pragma("unroll") for (int m = 0; m < 4; ++m) { const int lr = wr * 64 + m * 16 + fr; \
            _Pragma("unroll") for (int bj = 0; bj < 2; ++bj) _Pragma("unroll") for (int n = 0; n < 2; ++n) \
                *(PG8_LAS f32x4*)(Y + lr * YP + bj * HALF + wc * 32 + 8 * fq + 4 * n) = acc[ai_][bj][m][n] * gp[bj][n]; } } while (0)
        if (tid < 256) __hip_atomic_store(ystat + (size_t)(rowbase + tid) * 4 + u.pn, (P[tid * 4 + 0] + P[tid * 4 + 1]) + (P[tid * 4 + 2] + P[tid * 4 + 3]), __ATOMIC_RELAXED, __HIP_MEMORY_SCOPE_AGENT);
        asm volatile("s_waitcnt vmcnt(0)" ::: "memory");
        unsigned* pc = cnt + 64 * (u.pm & 63);
        if (lane == 0) __hip_atomic_fetch_add(pc, 1u, __ATOMIC_RELAXED, __HIP_MEMORY_SCOPE_AGENT);
        SEAM_STAGE(0);
        if (wid == 0) {
            unsigned spins = 0;
            while ((unsigned)__builtin_amdgcn_readfirstlane(__hip_atomic_load(pc, __ATOMIC_RELAXED, __HIP_MEMORY_SCOPE_AGENT)) < 32u) { __builtin_amdgcn_s_sleep(1); if (++spins > (1u << 24)) break; }
        }
        asm volatile("s_waitcnt vmcnt(0) lgkmcnt(0)" ::: "memory"); __builtin_amdgcn_s_barrier(); asm volatile("" ::: "memory");
        if (tid < 256) {
            const float* sl = ystat + (size_t)(rowbase + tid) * 4;
            const float t0 = __hip_atomic_load(sl + 0, __ATOMIC_RELAXED, __HIP_MEMORY_SCOPE_AGENT), t1 = __hip_atomic_load(sl + 1, __ATOMIC_RELAXED, __HIP_MEMORY_SCOPE_AGENT),
                        t2 = __hip_atomic_load(sl + 2, __ATOMIC_RELAXED, __HIP_MEMORY_SCOPE_AGENT), t3 = __hip_atomic_load(sl + 3, __ATOMIC_RELAXED, __HIP_MEMORY_SCOPE_AGENT);
            R[tid] = rstd_of((f32x4){t0, t1, t2, t3});
        }
        __syncthreads();
#pragma unroll
        for (int ai = 0; ai < 2; ++ai) {
            if (ai == 1) { SEAM_STAGE(1); __syncthreads(); }
#pragma unroll
            for (int kb = 0; kb < 2; ++kb) {
                f32x4 h[8], y[8]; float rr[8];
                const size_t off0 = (size_t)(rowbase + ai * HALF + wid * 16 + kb * 8) * DM + colbase + 4 * lane;
                if (hin32) {
#pragma unroll
                    for (int k = 0; k < 8; ++k) h[k] = *(const f32x4*)(hin32 + off0 + (size_t)k * DM);
                } else {
#pragma unroll
                    for (int k = 0; k < 8; ++k) { const uint2 q = *(const uint2*)(hinb + off0 + (size_t)k * DM); h[k] = (f32x4){bfl(q.x), bfh(q.x), bfl(q.y), bfh(q.y)}; }
                }
#pragma unroll
                for (int k = 0; k < 8; ++k) { const int lr = wid * 16 + kb * 8 + k; y[k] = *(const PG8_LAS f32x4*)(Y + lr * YP + 4 * lane); rr[k] = R[ai * HALF + lr]; }
#pragma unroll
                for (int k = 0; k < 8; ++k) h[k] = h[k] + y[k] * rr[k];
                if (hout32) {
#pragma unroll
                    for (int k = 0; k < 8; ++k) *(f32x4*)(hout32 + off0 + (size_t)k * DM) = h[k];
                } else {
#pragma unroll
                    for (int k = 0; k < 8; ++k) { uint2 w; w.x = cvt_pk(h[k][0], h[k][1]); w.y = cvt_pk(h[k][2], h[k][3]); *(uint2*)(houtb + off0 + (size_t)k * DM) = w; }
                }
                if (hstat) {
                    float sq[8];
#pragma unroll
                    for (int k = 0; k < 8; ++k) sq[k] = (h[k][0] * h[k][0] + h[k][1] * h[k][1]) + (h[k][2] * h[k][2] + h[k][3] * h[k][3]);
#pragma unroll
                    for (int o = 1; o < 64; o <<= 1)
#pragma unroll
                        for (int k = 0; k < 8; ++k) sq[k] += lane_xor(sq[k], lane, o);
                    if (lane == 0) {
#pragma unroll
                        for (int k = 0; k < 8; ++k) hstat[(size_t)(rowbase + ai * HALF + wid * 16 + kb * 8 + k) * 4 + u.pn] = sq[k];
                    }
                }
            }
            __syncthreads();
        }
#undef SEAM_STAGE
    }
};

struct PoolOrder {
    int c;
    __device__ bool next(int i, Unit& u) const { if (i > 0 || c >= 256) return false; u.pm = (c & 3) * 64 + (c >> 2); u.pn = c & 3; return true; }
    __device__ __forceinline__ void a_ready(const Unit&) const {}
    __device__ __forceinline__ void done(const Unit&) const {}
};

template <class Epi, class Sched, bool ALIGN_EPI = false, bool SP2 = false>
__device__ __forceinline__ void gemm_phase(PG8_LAS unsigned char* lds, const Gemm g, const Sched& S, const Epi& E) {
    int tid_ = threadIdx.x; asm volatile("" : "+v"(tid_));
    const unsigned lds_u = (unsigned)(size_t)lds;
    const int tid = tid_, wid = __builtin_amdgcn_readfirstlane(tid >> 6), lane = tid & 63, wr = wid >> 2, wc = wid & 3, fr = lane & 15, fq = lane >> 4;
    const int K = g.K, nt = K / BK;
    unsigned voffA[2], voffB[2];
#pragma unroll
    for (int i = 0; i < 2; ++i) { int R, C; stage_rc(tid * 16 + i * 8192, R, C); const int Rb = Epi::PERM ? ((R & ~31) + perm32(R & 31)) : R;
        voffA[i] = (unsigned)(R * K + C) * 2u; voffB[i] = (unsigned)(Rb * K + C) * 2u; }
    const size_t kstep = (size_t)(BK * 2);
    const size_t hstep = (size_t)HALF * K * 2;
    const size_t tstep = 2 * hstep;
    const unsigned ldsw = (unsigned)wid * 1024u;
    const int aoff = lds_byte(wr * 64 + fr, fq * 8), boff = lds_byte(wc * 32 + fr, fq * 8);
#define PG8_SA(b, h) (((b) * 2 + (h)) * HTB)
#define PG8_SB(b, h) ((4 + (b) * 2 + (h)) * HTB)
#define PG8_STAGE(bufoff, gbase, voff) do { _Pragma("unroll") for (int _i = 0; _i < 2; ++_i) \
        glds16s((const void*)(gbase), (voff)[_i], lds_u + (unsigned)(bufoff) + ldsw + (unsigned)(_i * 8192)); } while (0)
#define PG8_LDA(dst, b, h) do { _Pragma("unroll") for (int m = 0; m < 4; ++m) _Pragma("unroll") for (int k = 0; k < 2; ++k) dst[m][k] = *(const PG8_LAS bf16x8*)(lds + PG8_SA(b, h) + aoff + m * 2048 + k * 1024); } while (0)
#define PG8_LDB(dst, b, h) do { _Pragma("unroll") for (int n = 0; n < 2; ++n) _Pragma("unroll") for (int k = 0; k < 2; ++k) dst[n][k] = *(const PG8_LAS bf16x8*)(lds + PG8_SB(b, h) + boff + n * 2048 + k * 1024); } while (0)
#define PG8_MMA(ai, bj, At, Bt) do { __builtin_amdgcn_s_setprio(1); _Pragma("unroll") for (int m = 0; m < 4; ++m) _Pragma("unroll") for (int n = 0; n < 2; ++n) _Pragma("unroll") for (int k = 0; k < 2; ++k) \
        acc[ai][bj][m][n] = __builtin_amdgcn_mfma_f32_16x16x32_bf16(Bt[n][k], At[m][k], acc[ai][bj][m][n], 0, 0, 0); __builtin_amdgcn_s_setprio(0); } while (0)
#define PG8_WAIT_V(n) asm volatile("s_waitcnt vmcnt(" #n ")" ::: "memory")
#define PG8_WAIT_L(n) asm volatile("s_waitcnt lgkmcnt(" #n ")" ::: "memory")
#define PG8_BAR __builtin_amdgcn_s_barrier()
#define PG8_SCHED __builtin_amdgcn_sched_barrier(0)
    Unit cur, nxt; int ui = 0;
    if (!S.next(0, cur)) return;
    f32x4 acc[2][2][4][2];
#pragma unroll
    for (int a = 0; a < 2; ++a)
#pragma unroll
        for (int b = 0; b < 2; ++b)
#pragma unroll
            for (int m = 0; m < 4; ++m)
#pragma unroll
                for (int n = 0; n < 2; ++n) acc[a][b][m][n] = (f32x4){0.f, 0.f, 0.f, 0.f};
    bf16x8 At[4][2], B0[2][2], B1[2][2];
    const char* cA = (const char*)g.A + (size_t)cur.pm * tstep; const char* cB = (const char*)g.Bt + (size_t)cur.pn * tstep;
    S.a_ready(cur);
    typename Epi::Pre pre = E.prefetch(cur, tid);
    if constexpr (SP2) {
        PG8_STAGE(PG8_SB(0, 0), cB, voffB); PG8_STAGE(PG8_SB(0, 1), cB + hstep, voffB); PG8_STAGE(PG8_SA(0, 0), cA, voffA); PG8_STAGE(PG8_SA(0, 1), cA + hstep, voffA);
        if (wr == 1) PG8_BAR;
        PG8_WAIT_V(2); PG8_BAR;
        PG8_STAGE(PG8_SB(1, 0), cB + kstep, voffB); PG8_STAGE(PG8_SA(1, 0), cA + kstep, voffA); PG8_STAGE(PG8_SB(1, 1), cB + hstep + kstep, voffB);
        PG8_WAIT_V(6); PG8_BAR;
    } else {
        PG8_STAGE(PG8_SB(0, 0), cB, voffB); PG8_STAGE(PG8_SA(0, 0), cA, voffA); PG8_STAGE(PG8_SB(0, 1), cB + hstep, voffB); PG8_STAGE(PG8_SA(0, 1), cA + hstep, voffA);
        if (wr == 1) PG8_BAR;
        PG8_WAIT_V(4); PG8_BAR;
        PG8_STAGE(PG8_SB(1, 0), cB + kstep, voffB); PG8_STAGE(PG8_SA(1, 0), cA + kstep, voffA); PG8_STAGE(PG8_SB(1, 1), cB + hstep + kstep, voffB);
        PG8_WAIT_V(6); PG8_BAR;
    }
    for (;;) {
        const bool has_next = S.next(ui + 1, nxt);
        const char* nA = has_next ? (const char*)g.A + (size_t)nxt.pm * tstep : cA; const char* nB = has_next ? (const char*)g.Bt + (size_t)nxt.pn * tstep : cB;
        for (int t = 0; t < nt; t += 2) {
            const bool last = (t == nt - 2);
            const char* a1 = cA + (size_t)(t + 1) * kstep;
            const char* a2 = last ? nA : cA + (size_t)(t + 2) * kstep; const char* b2 = last ? nB : cB + (size_t)(t + 2) * kstep;
            const char* a3 = a2 + kstep; const char* b3 = b2 + kstep;
            if (last && has_next) S.a_ready(nxt);
            if constexpr (SP2) {
            PG8_LDB(B0, 0, 0); PG8_LDB(B1, 0, 1); PG8_SCHED; PG8_LDA(At, 0, 0); PG8_STAGE(PG8_SA(1, 1), a1 + hstep, voffA);
            PG8_WAIT_V(8); PG8_WAIT_L(0); PG8_BAR; PG8_MMA(0, 0, At, B0); PG8_MMA(0, 1, At, B1); PG8_BAR; PG8_SCHED;
            PG8_LDA(At, 0, 1); PG8_STAGE(PG8_SB(0, 0), b2, voffB); PG8_STAGE(PG8_SB(0, 1), b2 + hstep, voffB); PG8_STAGE(PG8_SA(0, 0), a2, voffA);
            PG8_WAIT_V(8); PG8_WAIT_L(0); PG8_BAR; PG8_MMA(1, 0, At, B0); PG8_MMA(1, 1, At, B1); PG8_BAR; PG8_SCHED;
            PG8_LDB(B0, 1, 0); PG8_LDB(B1, 1, 1); PG8_SCHED; PG8_LDA(At, 1, 0); PG8_STAGE(PG8_SA(0, 1), a2 + hstep, voffA);
            PG8_WAIT_V(8); PG8_WAIT_L(0); PG8_BAR; PG8_MMA(0, 0, At, B0); PG8_MMA(0, 1, At, B1); PG8_BAR; PG8_SCHED;
            PG8_LDA(At, 1, 1); PG8_STAGE(PG8_SB(1, 0), b3, voffB); PG8_STAGE(PG8_SB(1, 1), b3 + hstep, voffB); PG8_STAGE(PG8_SA(1, 0), a3, voffA);
            PG8_WAIT_V(8); PG8_WAIT_L(0); PG8_BAR; PG8_MMA(1, 0, At, B0); PG8_MMA(1, 1, At, B1); PG8_BAR; PG8_SCHED;
            } else {
            PG8_LDB(B0, 0, 0); PG8_SCHED; PG8_LDA(At, 0, 0); PG8_STAGE(PG8_SA(1, 1), a1 + hstep, voffA);
            PG8_WAIT_L(8); PG8_BAR; PG8_WAIT_L(0); PG8_MMA(0, 0, At, B0); PG8_BAR; PG8_SCHED;
            PG8_LDB(B1, 0, 1); PG8_STAGE(PG8_SB(0, 0), b2, voffB);
            PG8_BAR; PG8_WAIT_L(0); PG8_MMA(0, 1, At, B1); PG8_BAR;
            PG8_LDA(At, 0, 1); PG8_STAGE(PG8_SA(0, 0), a2, voffA);
            PG8_BAR; PG8_WAIT_L(0); PG8_MMA(1, 0, At, B0); PG8_BAR; PG8_SCHED;
            PG8_STAGE(PG8_SB(0, 1), b2 + hstep, voffB);
            PG8_WAIT_V(6); PG8_BAR; PG8_MMA(1, 1, At, B1); PG8_BAR;
            PG8_LDB(B0, 1, 0); PG8_SCHED; PG8_LDA(At, 1, 0); PG8_STAGE(PG8_SA(0, 1), a2 + hstep, voffA);
            PG8_WAIT_L(8); PG8_BAR; PG8_WAIT_L(0); PG8_MMA(0, 0, At, B0); PG8_BAR; PG8_SCHED;
            PG8_LDB(B1, 1, 1); PG8_STAGE(PG8_SB(1, 0), b3, voffB);
            PG8_BAR; PG8_WAIT_L(0); PG8_MMA(0, 1, At, B1); PG8_BAR;
            PG8_LDA(At, 1, 1); PG8_STAGE(PG8_SA(1, 0), a3, voffA);
            PG8_BAR; PG8_WAIT_L(0); PG8_MMA(1, 0, At, B0); PG8_BAR; PG8_SCHED;
            PG8_STAGE(PG8_SB(1, 1), b3 + hstep, voffB);
            PG8_WAIT_V(6); PG8_BAR; PG8_MMA(1, 1, At, B1); PG8_BAR;
            }
        }
        if constexpr (ALIGN_EPI) { if (wr == 0) PG8_BAR; }
        if constexpr (!Epi::AFTER_DRAIN) { E(acc, cur, wr, wc, fr, fq, pre, tid); S.done(cur); }
        if (!has_next) break;
#pragma unroll
        for (int a = 0; a < 2; ++a)
#pragma unroll
            for (int b = 0; b < 2; ++b)
#pragma unroll
                for (int m = 0; m < 4; ++m)
#pragma unroll
                    for (int n = 0; n < 2; ++n) acc[a][b][m][n] = (f32x4){0.f, 0.f, 0.f, 0.f};
        cur = nxt; cA = nA; cB = nB; ++ui;
        pre = E.prefetch(cur, tid);
        if constexpr (ALIGN_EPI) { if (wr == 1) PG8_BAR; }
    }
    PG8_WAIT_V(0);
    if constexpr (!ALIGN_EPI) { if (wr == 0) PG8_BAR; }
    PG8_BAR;
    if constexpr (Epi::AFTER_DRAIN) { E.fused(acc, cur, wr, wc, fr, fq, lds, wid, lane); S.done(cur); }
#undef PG8_SA
#undef PG8_SB
#undef PG8_STAGE
#undef PG8_LDA
#undef PG8_LDB
#undef PG8_MMA
#undef PG8_WAIT_V
#undef PG8_WAIT_L
#undef PG8_BAR
#undef PG8_SCHED
}
}

using pg8::bf16_t; using pg8::f32x4; using pg8::u32x4; using pg8::cvt_pk_bf16;
constexpr int M = 16384, D = 1024, FF = 2816, SEQ = 4096;
#ifndef TAIL_N
#define TAIL_N 528
#endif
#ifndef POOL_SP2
#define POOL_SP2 true
#endif
#ifndef GU_SP2
#define GU_SP2 true
#endif
constexpr int LDS_BYTES = 147456;
constexpr size_t MiB = 1u << 20;
constexpr size_t WS_BAR = 0, BAR_BYTES = XCD_BAR_WORDS * 4;
constexpr size_t WS_CNT = 16 * 1024, CNT_BANK_WORDS = 64 * 64;
constexpr size_t ZERO_BYTES = 128 * 1024;
constexpr size_t WS_ZEROS = 120 * 1024;
constexpr size_t WS_YSTAT = 128 * 1024, WS_HSTAT = 384 * 1024;
constexpr size_t WS_BS = 640 * 1024;
constexpr int LDS_MISC = 147456 - 1024, LDS_TAB = 147456 - 2048;
constexpr size_t WS_WPOOL = 1 * MiB, WS_WOUT = 2 * MiB, WS_WIN = 4 * MiB, WS_WGU0 = 10 * MiB, WS_WGU1 = 21 * MiB, WS_WDN0 = 32 * MiB, WS_WDN1 = 38 * MiB;
constexpr size_t WS_AN = 44 * MiB;
constexpr size_t WS_POOLA = 76 * MiB;
constexpr size_t WS_ACT = 108 * MiB;
constexpr size_t WS_END = 196 * MiB;

struct Args { const float* x; const float* gains; const float* pool_w; const float* pool_scale; const float* conv_in_w; const float* conv_w; const float* conv_out_w;
              const float* gu_w; const float* dn_w; float* out; unsigned char* ws; };

__device__ __forceinline__ float wave_sum(float v) {
#pragma unroll
    for (int o = 1; o < 64; o <<= 1) v += __shfl_xor(v, o);
    return v;
}

struct TrItem { const float* W; bf16_t* WT; int K, N, kb, nsrc0, ndst0; const float* gain; };
constexpr int I_POOL = 16, I_GU = 352, I_DN = 176, I_IN = 192, I_OUT = 64, NITEMS = I_POOL + 2 * I_GU + 2 * I_DN + I_IN + I_OUT;
template <int SET> __device__ __forceinline__ bool tr_decode(int vi, const Args& a, TrItem& t) {
    int it;
    if (SET == 0) { if (vi >= I_POOL + I_GU) return false; it = vi; }
    else if (SET == 1) { if (vi >= I_DN + I_IN + I_OUT + I_GU) return false;
        it = vi < I_DN ? I_POOL + 2 * I_GU + vi : (vi < I_DN + I_IN + I_OUT ? I_POOL + 2 * I_GU + 2 * I_DN + (vi - I_DN) : I_POOL + I_GU + (vi - I_DN - I_IN - I_OUT)); }
    else { if (vi >= I_DN) return false; it = I_POOL + 2 * I_GU + I_DN + vi; }
    int r = it; unsigned char* ws = a.ws;
    if (r < I_POOL) { const int g = r >> 2, rb = (r >> 1) & 1; t = TrItem{a.pool_w + (size_t)g * 65536, (bf16_t*)(ws + WS_WPOOL) + (size_t)g * 65536, 256, 256, r & 1, 128 * rb, 128 * rb, nullptr}; return true; } r -= I_POOL;
    if (r < 2 * I_GU) { const int l = r / I_GU; r -= l * I_GU; const int rb = r >> 3, pn = rb >> 1, bj = rb & 1;
        t = TrItem{a.gu_w + (size_t)l * D * 2 * FF, (bf16_t*)(ws + (l ? WS_WGU1 : WS_WGU0)), D, 2 * FF, r & 7, bj * FF + 128 * pn, 128 * rb, a.gains + (l * 4 + 2) * D}; return true; } r -= 2 * I_GU;
    if (r < 2 * I_DN) { const int l = r / I_DN; r -= l * I_DN; const int rb = r / 22;
        t = TrItem{a.dn_w + (size_t)l * FF * D, (bf16_t*)(ws + (l ? WS_WDN1 : WS_WDN0)), FF, D, r % 22, 128 * rb, 128 * rb, nullptr}; return true; } r -= 2 * I_DN;
    if (r < I_IN) { const int rb = r >> 3; int ns;
        if (rb < 8) ns = 128 * rb; else { const int q = (rb - 8) >> 1, bj = (rb - 8) & 1; ns = D + bj * D + 128 * q; }
        t = TrItem{a.conv_in_w, (bf16_t*)(ws + WS_WIN), D, 3 * D, r & 7, ns, 128 * rb, a.gains + 4 * D}; return true; } r -= I_IN;
    { const int rb = r >> 3; t = TrItem{a.conv_out_w, (bf16_t*)(ws + WS_WOUT), D, D, r & 7, 128 * rb, 128 * rb, nullptr}; return true; }
}
__device__ __forceinline__ void tr_load(const TrItem& t, f32x4 (&v)[8], int tid) {
    const int lr = tid >> 5, lc = (tid & 31) * 4;
    const float* p = t.W + (size_t)(t.kb * 128 + 2 * lr) * t.N + t.nsrc0 + lc;
#pragma unroll
    for (int i = 0; i < 4; ++i) { v[2 * i] = __builtin_nontemporal_load((const f32x4*)(p + (size_t)(32 * i) * t.N)); v[2 * i + 1] = __builtin_nontemporal_load((const f32x4*)(p + (size_t)(32 * i + 1) * t.N)); }    if (t.gain) {
        const float* gk = t.gain + t.kb * 128 + 2 * lr;
#pragma unroll
        for (int i = 0; i < 4; ++i) { v[2 * i] = v[2 * i] * gk[32 * i]; v[2 * i + 1] = v[2 * i + 1] * gk[32 * i + 1]; }
    }
}
template <int SET> __device__ __forceinline__ void tr_run(const Args& a, int first, int stride, float* scr_) {
    unsigned* scr = (unsigned*)scr_;
    int tid_ = threadIdx.x; asm volatile("" : "+v"(tid_));
    const int tid = tid_, lr = tid >> 5, lc = (tid & 31) * 4;
    const int c = (tid >> 3) & 15, nb = (tid & 7) + 8 * (tid >> 7);
    TrItem cur, nxt; f32x4 v[8];
    int it = first; bool have = tr_decode<SET>(it, a, cur);
    if (have) tr_load(cur, v, tid);
    while (have) {
#pragma unroll
        for (int i = 0; i < 4; ++i) { unsigned* s = scr + (lr + 16 * i) * 129 + lc;
            s[0] = cvt_pk_bf16(v[2 * i][0], v[2 * i + 1][0]); s[1] = cvt_pk_bf16(v[2 * i][1], v[2 * i + 1][1]); s[2] = cvt_pk_bf16(v[2 * i][2], v[2 * i + 1][2]); s[3] = cvt_pk_bf16(v[2 * i][3], v[2 * i + 1][3]); }
        __syncthreads();
        it += stride; const bool hn = tr_decode<SET>(it, a, nxt);
        if (hn) tr_load(nxt, v, tid);
#pragma unroll
        for (int j = 0; j < 4; ++j) {
            const int n = nb + 32 * j; const unsigned* s = scr + (4 * c) * 129 + n;
            u32x4 o; o.x = s[0]; o.y = s[129]; o.z = s[2 * 129]; o.w = s[3 * 129];
            *(u32x4*)(cur.WT + (size_t)(cur.ndst0 + n) * cur.K + cur.kb * 128 + 8 * c) = o;
        }
        __syncthreads();
        cur = nxt; have = hn;
    }
}

__device__ __forceinline__ void pool_prep_chunk(const float* __restrict__ x, const float* __restrict__ g0, bf16_t* __restrict__ poolA, int chunk, float* HN) {
    int tid_ = threadIdx.x; asm volatile("" : "+v"(tid_));
    const int tid = tid_, lane = tid & 63, wave = tid >> 6;
    const int t0 = chunk * 64, p0 = t0 & (SEQ - 1);
    const bool halo = p0 > 0;
    const int cq = tid & 255, hh = tid >> 8, g = cq >> 6, w = 2 << g;
    bf16_t* opb = poolA + ((size_t)g * M + t0) * 256 + ((4 * cq) & 255);
    f32x4 g0v[4];
#pragma unroll
    for (int j = 0; j < 4; ++j) g0v[j] = *(const f32x4*)(g0 + 4 * lane + 256 * j);
    f32x4 rv[2][2][4];
#define PP_ISSUE(blk) do { _Pragma("unroll") for (int q = 0; q < 2; ++q) { const f32x4* xr = (const f32x4*)(x + (size_t)(t0 + 16 * ((blk) - 1) + 2 * wave + q) * D) + lane; \
        _Pragma("unroll") for (int j = 0; j < 4; ++j) rv[(blk) & 1][q][j] = xr[64 * j]; } } while (0)
    if (halo) PP_ISSUE(0);
    else {
#pragma unroll
        for (int q = 0; q < 2; ++q)
#pragma unroll
            for (int j = 0; j < 4; ++j) rv[0][q][j] = (f32x4){0.f, 0.f, 0.f, 0.f};
    }
    PP_ISSUE(1);
#pragma unroll
    for (int b = 0; b < 5; ++b) {
        const int slot = b & 1;
#pragma unroll
        for (int q = 0; q < 2; ++q) {
            float s = 0.f;
#pragma unroll
            for (int j = 0; j < 4; ++j) { const f32x4 v = rv[b & 1][q][j]; s += (v[0] * v[0] + v[1] * v[1]) + (v[2] * v[2] + v[3] * v[3]); }
            s = wave_sum(s);
            const float rs = rsqrtf(s * (1.0f / D) + 1e-6f);
#pragma unroll
            for (int j = 0; j < 4; ++j) *(f32x4*)(HN + (slot * 16 + 2 * wave + q) * 1024 + 4 * lane + 256 * j) = rv[b & 1][q][j] * rs * g0v[j];
        }
        if (b < 3) PP_ISSUE(b + 2);
        __syncthreads();
        if (b >= 1) {
            const float* Xc = HN + slot * 16 * 1024 + 4 * cq; const float* Xp = HN + (slot ^ 1) * 16 * 1024 + 4 * cq;
            const int r0 = 8 * hh, pbase = p0 + 16 * (b - 1) + r0;
#define PP_ROW(r_) (*(const f32x4*)(((r_) < 0 ? Xp : Xc) + ((r_) & 15) * 1024))
            f32x4 s = {0.f, 0.f, 0.f, 0.f};
#pragma unroll
            for (int q = 15; q >= 1; --q) { const float wq = (q < w) ? 1.f : 0.f; s += PP_ROW(r0 - q) * wq; }
#pragma unroll
            for (int i = 0; i < 8; ++i) {
                const int p = pbase + i;
                const f32x4 cur = PP_ROW(r0 + i);
                const f32x4 win = s + cur;
                const float inv = 1.0f / (float)((p + 1 < w) ? p + 1 : w);
                const f32x4 o = win * inv - cur;
                uint2 pk; pk.x = cvt_pk_bf16(o[0], o[1]); pk.y = cvt_pk_bf16(o[2], o[3]);
                *(uint2*)(opb + (size_t)(16 * (b - 1) + r0 + i) * 256) = pk;
                const int ro = r0 + i - w + 1;
                s = win - PP_ROW(ro);
            }
#undef PP_ROW
        }
        __syncthreads();
        __builtin_amdgcn_sched_barrier(0);
    }
#undef PP_ISSUE
}

__device__ __forceinline__ float bf_lo(unsigned w) { return __builtin_bit_cast(float, w << 16); }
__device__ __forceinline__ float bf_hi(unsigned w) { return __builtin_bit_cast(float, w & 0xffff0000u); }

__device__ __forceinline__ void conv_patch(const bf16_t* __restrict__ Bs, const bf16_t* __restrict__ Ub, const float* __restrict__ taps, bf16_t* __restrict__ G, int pm) {
    int tid_ = threadIdx.x; asm volatile("" : "+v"(tid_));
    if (pm & 15) {
        const int r = tid_ >> 8, c4 = (tid_ & 255) * 4; const size_t t = (size_t)pm * 256 + r;
        const uint2 b = *(const uint2*)(Bs + (size_t)(pm * 2 + r) * D + c4);
        const uint2 x0 = *(const uint2*)(Ub + t * D + c4), x1 = *(const uint2*)(Ub + (t - 1) * D + c4), x2 = *(const uint2*)(Ub + (t - 2) * D + c4);
        const f32x4 w0 = *(const f32x4*)(taps + c4), w1 = *(const f32x4*)(taps + D + c4), w2 = *(const f32x4*)(taps + 2 * D + c4);
        const f32x4 u0 = {bf_lo(x0.x), bf_hi(x0.x), bf_lo(x0.y), bf_hi(x0.y)}, u1 = {bf_lo(x1.x), bf_hi(x1.x), bf_lo(x1.y), bf_hi(x1.y)}, u2 = {bf_lo(x2.x), bf_hi(x2.x), bf_lo(x2.y), bf_hi(x2.y)};
        const f32x4 bv = {bf_lo(b.x), bf_hi(b.x), bf_lo(b.y), bf_hi(b.y)};
        const f32x4 g = ((w0 * u2 + w1 * u1) + w2 * u0) * bv;
        uint2 o; o.x = cvt_pk_bf16(g[0], g[1]); o.y = cvt_pk_bf16(g[2], g[3]);
        *(uint2*)(G + t * D + c4) = o;
    }
    asm volatile("s_waitcnt vmcnt(0)" ::: "memory");
    __syncthreads();
}

__global__ void __launch_bounds__(512, 2) fwd_megakernel(Args a) {
    extern __shared__ __attribute__((aligned(16))) unsigned char lds_raw[];
    LAS unsigned char* lds = (LAS unsigned char*)lds_raw;
    cg::grid_group grid = cg::this_grid();
    if (threadIdx.x < 2) ((volatile LAS unsigned*)(lds + LDS_MISC))[threadIdx.x] = 0u;
    __syncthreads();
    const XcdBarrier xbar = xcd_barrier_post((unsigned*)(a.ws + WS_BAR), (volatile LAS unsigned*)(lds + LDS_MISC));
    const int bid = blockIdx.x, G = gridDim.x;
    unsigned char* ws = a.ws;
    unsigned* cntw = (unsigned*)(ws + WS_CNT);
    float* ystat = (float*)(ws + WS_YSTAT); float* hstat = (float*)(ws + WS_HSTAT);
    bf16_t* Wpool = (bf16_t*)(ws + WS_WPOOL); bf16_t* Wout = (bf16_t*)(ws + WS_WOUT); bf16_t* Win = (bf16_t*)(ws + WS_WIN);
    bf16_t* AN = (bf16_t*)(ws + WS_AN); bf16_t* POOLA = (bf16_t*)(ws + WS_POOLA); bf16_t* ACT = (bf16_t*)(ws + WS_ACT);
    bf16_t* UB = (bf16_t*)(ws + WS_ACT + 32 * MiB); bf16_t* GB = POOLA; bf16_t* BS = (bf16_t*)(ws + WS_BS);

#ifndef NO_P0
#ifndef REP_P0
#define REP_P0 1
#endif
    for (int rep_ = 0; rep_ < REP_P0; ++rep_) {
        float* scr = (float*)lds_raw;
#ifndef REP_PREP
#define REP_PREP 1
#endif
        for (int rp_ = 0; rp_ < REP_PREP; ++rp_)
        for (int ch = bid; ch < M / 64; ch += G) pool_prep_chunk(a.x, a.gains, POOLA, ch, (float*)lds_raw);
        tr_run<0>(a, bid, G, scr);
    }
#endif
    if (a.ws == nullptr) grid.sync();
    xcd_barrier(xbar);

#ifndef NO_POOL
#ifndef REP_POOL
#define REP_POOL 1
#endif
#ifndef REP_SYNC
#define REP_SYNC 0
#endif
    for (int rep_ = 0; rep_ < REP_SYNC; ++rep_) xcd_barrier(xbar);
    for (int rep_ = 0; rep_ < REP_POOL; ++rep_) {
        if (rep_) xcd_barrier(xbar);
        pg8::Gemm g{POOLA, Wpool, 4 * M, 256, 256}; pg8::PoolOrder S{bid};
        pg8::EpiSeam E{a.x, nullptr, nullptr, AN, a.gains + 1 * D, a.pool_scale, ystat, hstat, cntw + 0 * CNT_BANK_WORDS};
        pg8::gemm_phase<pg8::EpiSeam, pg8::PoolOrder, false, true>(lds, g, S, E);
    }
    xcd_barrier(xbar);
#endif

#pragma unroll 1
    for (int l = 0; l < 2; ++l) {
#ifndef NO_L1MIX
        if (l == 1) {
#ifndef REP_INPROJ
#define REP_INPROJ 1
#endif
            for (int rep_ = 0; rep_ < REP_INPROJ; ++rep_) {
                pg8::Gemm g{AN, Win, M, 3 * D, D}; pg8::TripleOrder S{bid};
                pg8::EpiInProj E{GB, UB, BS, a.conv_w, hstat, (LAS float*)(lds + LDS_TAB)};
                pg8::gemm_phase<pg8::EpiInProj, pg8::TripleOrder, true, true>(lds, g, S, E);
            }
            xcd_barrier(xbar);
            {
                pg8::Gemm g{GB, Wout, M, D, D}; pg8::StaticOrder S; S.init(M, D, G, bid);
                { pg8::Unit u0; if (S.next(0, u0)) conv_patch(BS, UB, a.conv_w, GB, u0.pm); }
                pg8::EpiSeam E{nullptr, AN, nullptr, AN, a.gains + 5 * D, nullptr, ystat, hstat, cntw + 1 * CNT_BANK_WORDS};
                pg8::gemm_phase<pg8::EpiSeam, pg8::StaticOrder, false, true>(lds, g, S, E);
            }
            xcd_barrier(xbar);
        }
#endif
#ifndef NO_FFN
#ifndef REP_GU
#define REP_GU 1
#endif
        for (int rep_ = 0; rep_ < REP_GU; ++rep_) {
            pg8::Gemm g{AN, (const bf16_t*)(ws + (l ? WS_WGU1 : WS_WGU0)), M, 2 * FF, D}; pg8::StaticOrder S; S.init(M, 2 * FF, G, bid);
            pg8::EpiSwiGLU E{ACT, hstat, (LAS float*)(lds + LDS_TAB)};
            pg8::gemm_phase<pg8::EpiSwiGLU, pg8::StaticOrder, true, GU_SP2>(lds, g, S, E);
        }
        if (bid >= G / 2) { if (l == 0) tr_run<1>(a, bid - G / 2, G - G / 2, (float*)lds_raw); else tr_run<2>(a, bid - G / 2, G - G / 2, (float*)lds_raw); }
        xcd_barrier(xbar);
        {
            pg8::Gemm g{ACT, (const bf16_t*)(ws + (l ? WS_WDN1 : WS_WDN0)), M, D, FF}; pg8::StaticOrder S; S.init(M, D, G, bid);
            pg8::EpiSeam E{nullptr, AN, l ? a.out : nullptr, l ? nullptr : AN, a.gains + (l * 4 + 3) * D, nullptr, ystat, l ? nullptr : hstat, cntw + (2 + l) * CNT_BANK_WORDS};
            pg8::gemm_phase<pg8::EpiSeam, pg8::StaticOrder, false, true>(lds, g, S, E);
        }
#endif
        if (l == 0) xcd_barrier(xbar);
    }
}

extern "C" void kernel_launch(void* const* d_in, const int* in_sizes, int n_in, void* d_out, int out_size, void* d_ws, size_t ws_size, hipStream_t stream) {
    static int grid = 0;
    if (grid == 0) {
        int dev = 0, cus = 0, per_cu = 0;
        (void)hipGetDevice(&dev);
        (void)hipDeviceGetAttribute(&cus, hipDeviceAttributeMultiprocessorCount, dev);
        (void)hipFuncSetAttribute((const void*)fwd_megakernel, hipFuncAttributeMaxDynamicSharedMemorySize, LDS_BYTES);
        (void)hipOccupancyMaxActiveBlocksPerMultiprocessor(&per_cu, (const void*)fwd_megakernel, 512, LDS_BYTES);
        (void)hipGetLastError();
        if (n_in != 9 || out_size != M * D || ws_size < WS_END || cus * (per_cu > 0 ? per_cu : 1) < 256)
            fprintf(stderr, "kernel_launch: unexpected problem/device: n_in %d out %d ws %zu cus %d per_cu %d\n", n_in, out_size, ws_size, cus, per_cu);
        grid = 256;
    }
    (void)hipMemsetAsync((char*)d_ws + WS_BAR, 0, ZERO_BYTES, stream);
    Args a{};
    a.x = (const float*)d_in[0]; a.gains = (const float*)d_in[1]; a.pool_w = (const float*)d_in[2]; a.pool_scale = (const float*)d_in[3];
    a.conv_in_w = (const float*)d_in[4]; a.conv_w = (const float*)d_in[5]; a.conv_out_w = (const float*)d_in[6]; a.gu_w = (const float*)d_in[7]; a.dn_w = (const float*)d_in[8];
    a.out = (float*)d_out; a.ws = (unsigned char*)d_ws;
    void* args[] = {&a};
    const hipError_t e = hipLaunchCooperativeKernel((const void*)fwd_megakernel, dim3(grid), dim3(512), args, LDS_BYTES, stream);
    if (e != hipSuccess) fprintf(stderr, "cooperative launch failed: %s (grid %d)\n", hipGetErrorString(e), grid);
}
```

```cpp
#include <hip/hip_runtime.h>
#include <hip/hip_cooperative_groups.h>
#include <cstdio>
#include <cstdint>
namespace cg = cooperative_groups;

#define LAS __attribute__((address_space(3)))
#define XB_TMO      128
#define XB_XCNT(j)  (256  + 64 * (j))
#define XB_XSUB(j)  (1280 + 64 * (j))
#define XB_XGEN(j)  (2304 + 64 * (j))
#define XB_TOP      3328
#define XB_TOPGEN   3392
#define XCD_BAR_WORDS 3456
#define XB_SPIN_CAP (1u << 18)

__device__ __forceinline__ unsigned xb_ld(unsigned* p)              { return __hip_atomic_load(p, __ATOMIC_RELAXED, __HIP_MEMORY_SCOPE_AGENT); }
__device__ __forceinline__ unsigned xb_add(unsigned* p, unsigned v) { return __hip_atomic_fetch_add(p, v, __ATOMIC_RELAXED, __HIP_MEMORY_SCOPE_AGENT); }
__device__ __forceinline__ unsigned xb_xcc_id() { return (unsigned)__builtin_amdgcn_s_getreg((3 << 11) | 20) & 0xFu; }
#define XB_SPIN(cond, bar) do { unsigned _sp = 0; while (cond) { __builtin_amdgcn_s_sleep(1); \
    if ((++_sp & 255u) == 0u) { if (xb_ld(&(bar)[XB_TMO])) break; if (_sp > XB_SPIN_CAP) { atomicAdd(&(bar)[XB_TMO], 1u); break; } } } } while (0)

struct XcdBarrier {
    unsigned* bar; unsigned x;
    volatile LAS unsigned* st;
};

__device__ __forceinline__ XcdBarrier xcd_barrier_post(unsigned* bar, volatile LAS unsigned* st) {
    XcdBarrier b; b.bar = bar; b.x = xb_xcc_id(); b.st = st;
    if (threadIdx.x == 0) (void)xb_add(&bar[XB_XCNT(b.x)], 1u);
    return b;
}
__device__ __forceinline__ void xcd_barrier_complete(unsigned* bar, unsigned x, unsigned& nloc, unsigned& nx) {
    const unsigned G = gridDim.x * gridDim.y * gridDim.z;
    unsigned sum, cnt, mine, sp = 0u;
    for (;;) {
        sum = 0u; cnt = 0u; mine = 0u;
#pragma unroll
        for (unsigned j = 0; j < 16; ++j) { const unsigned c = xb_ld(&bar[XB_XCNT(j)]); sum += c; cnt += (c > 0u) ? 1u : 0u; mine = (j == x) ? c : mine; }
        if (sum == G) break;
        __builtin_amdgcn_s_sleep(1);
        if ((++sp & 255u) == 0u) { if (xb_ld(&bar[XB_TMO])) break; if (sp > XB_SPIN_CAP) { atomicAdd(&bar[XB_TMO], 1u); break; } }
    }
    nloc = mine > 0u ? mine : 1u; nx = cnt > 0u ? cnt : 1u;
}

__device__ __forceinline__ void xcd_barrier(const XcdBarrier& b) {
    asm volatile("s_waitcnt vmcnt(0)" ::: "memory");
    __syncthreads();
    if (threadIdx.x == 0) {
        unsigned* bar = b.bar; unsigned bx = b.x; asm volatile("" : "+s"(bx));
        __builtin_amdgcn_s_waitcnt(0);
        unsigned nloc = b.st[0], nx = b.st[1];
        if (nloc == 0u) { xcd_barrier_complete(bar, bx, nloc, nx); b.st[0] = nloc; b.st[1] = nx; }
        const unsigned old = xb_add(&bar[XB_XSUB(bx)], 1u);
        const unsigned gen = old / nloc;
        if (old + 1u == (gen + 1u) * nloc) {
            __builtin_amdgcn_fence(__ATOMIC_RELEASE, "agent");
            asm volatile("s_waitcnt vmcnt(0)" ::: "memory");
            const unsigned og = xb_add(&bar[XB_TOP], 1u);
            const unsigned tg = og / nx;
            if (og + 1u == (tg + 1u) * nx) xb_add(&bar[XB_TOPGEN], 1u);
            else XB_SPIN(xb_ld(&bar[XB_TOPGEN]) == tg, bar);
            __builtin_amdgcn_fence(__ATOMIC_ACQUIRE, "agent");
            xb_add(&bar[XB_XGEN(bx)], 1u);
            asm volatile("s_waitcnt vmcnt(0)" ::: "memory");
        } else {
            XB_SPIN(xb_ld(&bar[XB_XGEN(bx)]) == gen, bar);
            __builtin_amdgcn_fence(__ATOMIC_ACQUIRE, "agent");
            asm volatile("s_waitcnt vmcnt(0)" ::: "memory");
        }
    }
    __syncthreads();
}
#ifndef PG8_WGM
#define PG8_WGM 8
#endif
namespace pg8 {
#define PG8_LAS __attribute__((address_space(3)))
typedef unsigned short bf16_t;
typedef short bf16x8 __attribute__((ext_vector_type(8)));
typedef float f32x4 __attribute__((ext_vector_type(4)));
typedef unsigned u32x4 __attribute__((ext_vector_type(4)));
constexpr int BM = 256, BK = 64, HALF = 128, HTB = HALF * BK * 2  , STAGE_BYTES = 8 * HTB, NXCD = 8, WGM = PG8_WGM;

__host__ __device__ __forceinline__ int lds_byte(int r, int c) { const int st = (r >> 4) * 2 + (c >> 5), rr = r & 15, cc = c & 31, ob = rr * 64 + cc * 2; return st * 1024 + (ob ^ (((ob >> 9) & 1) << 5)); }
__host__ __device__ __forceinline__ void stage_rc(int b, int& R, int& C) { const int st = b / 1024, sb = b % 1024, swz = sb ^ (((sb >> 9) & 1) << 5); R = (st >> 1) * 16 + swz / 64; C = (st & 1) * 32 + (swz % 64) / 2; }
__host__ __device__ __forceinline__ int perm32(int rho) { const int n = rho >> 4, i = rho & 15; return 8 * (i >> 2) + 4 * n + (i & 3); }

struct Unit { int pm, pn; };
struct Gemm { const bf16_t* A; const bf16_t* Bt; int M, N, K; };

struct StaticOrder {
    int nM, nN, nwg, G, c;
    __host__ __device__ void init(int M, int N, int G_, int c_) { nM = M / BM; nN = N / BM; nwg = nM * nN; G = G_; c = c_; }
    __host__ __device__ bool next(int i, Unit& u) const {
        const long L = (long)i * G + c; if (L >= nwg) return false;
        int wgid = (int)L; { const int q = nwg / NXCD, r = nwg % NXCD, xcd = wgid % NXCD, off = wgid / NXCD; wgid = (xcd < r ? xcd * (q + 1) : r * (q + 1) + (xcd - r) * q) + off; }
        const int nig = WGM * nN, gid = wgid / nig, fm = gid * WGM, gsz = (nM - fm) < WGM ? (nM - fm) : WGM;
        u.pm = fm + ((wgid % nig) % gsz); u.pn = (wgid % nig) / gsz; return true;
    }
    __device__ __forceinline__ void a_ready(const Unit&) const {}
    __device__ __forceinline__ void done(const Unit&) const {}
};

__device__ __forceinline__ unsigned cvt_pk_bf16(float lo, float hi) { unsigned r; asm volatile("v_cvt_pk_bf16_f32 %0, %1, %2" : "=v"(r) : "v"(lo), "v"(hi)); return r; }
__device__ __forceinline__ void glds16s(const void* sbase, unsigned voff, unsigned lds_dst) { unsigned keep;
    asm volatile("s_mov_b32 %0, m0\n\ts_mov_b32 m0, %3\n\ts_nop 0\n\tglobal_load_lds_dwordx4 %1, %2\n\ts_mov_b32 m0, %0" : "=&s"(keep) : "v"(voff), "s"(sbase), "s"(lds_dst) : "memory"); }
constexpr int MROWS = 16384, DM = 1024, DFF = 2816;
constexpr float RMS_EPS = 1e-6f;
#ifndef BGRP
#define BGRP 2
#endif
#ifndef UB_PITCH
#define UB_PITCH 1024
#endif
constexpr int UPITCH = UB_PITCH;

__device__ __forceinline__ float rstd_of(const f32x4 p) { return rsqrtf(((p[0] + p[1]) + (p[2] + p[3])) * (1.0f / DM) + RMS_EPS); }
__device__ __forceinline__ float row_rstd4(const float* st, int row) { return rstd_of(*(const f32x4*)(st + (size_t)row * 4)); }
__device__ __forceinline__ unsigned cvt_pk(float lo, float hi) { unsigned r; asm("v_cvt_pk_bf16_f32 %0, %1, %2" : "=v"(r) : "v"(lo), "v"(hi)); return r; }
__device__ __forceinline__ void load_rs8(const float* st, int row0, float (&rs)[2][4]) {
    f32x4 p[2][4];
#pragma unroll
    for (int ai = 0; ai < 2; ++ai)
#pragma unroll
        for (int m = 0; m < 4; ++m) p[ai][m] = *(const f32x4*)(st + (size_t)(row0 + ai * HALF + m * 16) * 4);
#pragma unroll
    for (int ai = 0; ai < 2; ++ai)
#pragma unroll
        for (int m = 0; m < 4; ++m) rs[ai][m] = rstd_of(p[ai][m]);
}

__device__ __forceinline__ void table_rs8(PG8_LAS float* T, const f32x4 st, int tid, int lrow0, float (&rs)[2][4]) {
    if (tid < 256) T[tid] = rstd_of(st);
    asm volatile("s_waitcnt lgkmcnt(0)" ::: "memory"); __builtin_amdgcn_s_barrier(); asm volatile("" ::: "memory");
#pragma unroll
    for (int ai = 0; ai < 2; ++ai)
#pragma unroll
        for (int m = 0; m < 4; ++m) rs[ai][m] = T[lrow0 + ai * HALF + m * 16];
}

__device__ __forceinline__ float lane_xor(float v, int lane, int mask) { return __builtin_bit_cast(float, __builtin_amdgcn_ds_bpermute((lane ^ mask) << 2, __builtin_bit_cast(int, v))); }

struct EpiSwiGLU {
    static constexpr bool PERM = true, AFTER_DRAIN = false;
    bf16_t* O; const float* hstat; PG8_LAS float* T;
    struct Pre { f32x4 st; };
    __device__ __forceinline__ Pre prefetch(const Unit& u, int tid) const { Pre p; p.st = (f32x4){1.f, 1.f, 1.f, 1.f}; if (tid < 256) p.st = *(const f32x4*)((const char*)hstat + (unsigned)(u.pm * BM + tid) * 16u); return p; }
    __device__ __forceinline__ void operator()(const f32x4 (&acc)[2][2][4][2], const Unit& u, int wr, int wc, int fr, int fq, const Pre& pre, int tid) const {
        asm volatile("" : "+v"(fr));
        const int row0 = u.pm * BM + wr * 64 + fr, col0 = u.pn * 128 + wc * 32 + 8 * fq;
        const unsigned vo = (unsigned)(row0 * DFF + col0) * 2u; char* obase = (char*)O;
        float rsv[2][4]; table_rs8(T, pre.st, tid, wr * 64 + fr, rsv);
#pragma unroll
        for (int ai = 0; ai < 2; ++ai)
#pragma unroll
            for (int m = 0; m < 4; ++m) {
                const float rs = rsv[ai][m];
                f32x4 o[2];
#pragma unroll
                for (int n = 0; n < 2; ++n) {
                    const f32x4 g = acc[ai][0][m][n] * rs, up = acc[ai][1][m][n] * rs;
                    f32x4 e = g * (-1.4426950408889634f);
                    e[0] = __builtin_amdgcn_exp2f(e[0]); e[1] = __builtin_amdgcn_exp2f(e[1]); e[2] = __builtin_amdgcn_exp2f(e[2]); e[3] = __builtin_amdgcn_exp2f(e[3]);
                    e = e + 1.0f;
                    e[0] = __builtin_amdgcn_rcpf(e[0]); e[1] = __builtin_amdgcn_rcpf(e[1]); e[2] = __builtin_amdgcn_rcpf(e[2]); e[3] = __builtin_amdgcn_rcpf(e[3]);
                    o[n] = (g * e) * up;
                }
                u32x4 w; w.x = cvt_pk(o[0][0], o[0][1]); w.y = cvt_pk(o[0][2], o[0][3]); w.z = cvt_pk(o[1][0], o[1][1]); w.w = cvt_pk(o[1][2], o[1][3]);
                *(u32x4*)(obase + (vo + (unsigned)((ai * HALF + m * 16) * DFF * 2))) = w;
            }
    }
};

__device__ __forceinline__ float bfl(unsigned w) { return __builtin_bit_cast(float, w << 16); }
__device__ __forceinline__ float bfh(unsigned w) { return __builtin_bit_cast(float, w & 0xffff0000u); }
template <int CTRL> __device__ __forceinline__ u32x4 dpp_row_shr(u32x4 old, u32x4 src) {
    u32x4 r;
#pragma unroll
    for (int c = 0; c < 4; ++c) r[c] = (unsigned)__builtin_amdgcn_update_dpp((int)old[c], (int)src[c], CTRL, 0xf, 0xf, false);
    return r;
}
struct EpiInProj {
    static constexpr bool PERM = true, AFTER_DRAIN = false;
    bf16_t* Gb; bf16_t* Ub; bf16_t* Bs; const float* taps; const float* hstat; PG8_LAS float* T;
    struct Pre { f32x4 st; };
    __device__ __forceinline__ Pre prefetch(const Unit& u, int tid) const { Pre p; p.st = (f32x4){1.f, 1.f, 1.f, 1.f}; if (tid < 256) p.st = *(const f32x4*)((const char*)hstat + (unsigned)(u.pm * BM + tid) * 16u); return p; }
    __device__ __forceinline__ void operator()(const f32x4 (&acc)[2][2][4][2], const Unit& u, int wr, int wc, int fr, int fq, const Pre& pre, int tid) const {
        asm volatile("" : "+v"(fr));
        const int lrow0 = wr * 64 + fr, row0 = u.pm * BM + lrow0;
        float rsv[2][4]; table_rs8(T, pre.st, tid, lrow0, rsv);
        if (u.pn >= 4) {
            const int col0 = (u.pn - 4) * 128 + wc * 32 + 8 * fq;
            const unsigned vo = (unsigned)(row0 * UPITCH + col0) * 2u; char* ub = (char*)Ub;
#pragma unroll
            for (int ai = 0; ai < 2; ++ai)
#pragma unroll
                for (int m = 0; m < 4; ++m) {
                    const float rs = rsv[ai][m];
                    const f32x4 v0 = (acc[ai][0][m][0] * rs) * (acc[ai][1][m][0] * rs), v1 = (acc[ai][0][m][1] * rs) * (acc[ai][1][m][1] * rs);
                    u32x4 w; w.x = cvt_pk(v0[0], v0[1]); w.y = cvt_pk(v0[2], v0[3]); w.z = cvt_pk(v1[0], v1[1]); w.w = cvt_pk(v1[2], v1[3]);
                    *(u32x4*)(ub + (vo + (unsigned)((ai * HALF + m * 16) * UPITCH * 2))) = w;
                }
        } else {
            const bool side = (u.pm & 15) != 0;
            const char* ubase = (const char*)Ub; char* gbase = (char*)Gb;
#pragma unroll
            for (int bj = 0; bj < 2; ++bj) {
                const int cb = u.pn * 256 + bj * HALF + wc * 32 + 8 * fq;
                const unsigned vo = (unsigned)(row0 * DM + cb) * 2u;
                const unsigned vu = (unsigned)(row0 * UPITCH + cb) * 2u;
                const f32x4 w0a = *(const f32x4*)(taps + cb), w0b = *(const f32x4*)(taps + cb + 4), w1a = *(const f32x4*)(taps + DM + cb), w1b = *(const f32x4*)(taps + DM + cb + 4),
                            w2a = *(const f32x4*)(taps + 2 * DM + cb), w2b = *(const f32x4*)(taps + 2 * DM + cb + 4);
#pragma unroll
                for (int ai = 0; ai < 2; ++ai) {
                    u32x4 x0[4], b1, b2;
#pragma unroll
                    for (int m = 0; m < 4; ++m) x0[m] = *(const u32x4*)(ubase + (vu + (unsigned)((ai * HALF + m * 16) * UPITCH * 2)));
                    {
                        const unsigned o = vu + (unsigned)((ai * HALF) * UPITCH * 2);
                        unsigned o1 = (fr == 0) ? o - (unsigned)(UPITCH * 2) : o, o2 = (fr < 2) ? o - (unsigned)(2 * UPITCH * 2) : o;
                        if (ai == 0) { o1 = lrow0 >= 1 ? o1 : o; o2 = lrow0 >= 2 ? o2 : o; }
                        b1 = *(const u32x4*)(ubase + o1); b2 = *(const u32x4*)(ubase + o2);
                    }
#pragma unroll
                    for (int m = 0; m < 4; ++m) {
                        const unsigned o = vo + (unsigned)((ai * HALF + m * 16) * DM * 2);
                        const float rs = rsv[ai][m];
                        const f32x4 ba = acc[ai][bj][m][0] * rs, bb = acc[ai][bj][m][1] * rs;
                        u32x4 x1, x2;
                        if (m == 0) { x1 = dpp_row_shr<0x111>(b1, x0[0]); x2 = dpp_row_shr<0x112>(b2, x0[0]); }
                        else { x1 = dpp_row_shr<0x111>(dpp_row_shr<0x121>(x0[m - 1], x0[m - 1]), x0[m]); x2 = dpp_row_shr<0x112>(dpp_row_shr<0x122>(x0[m - 1], x0[m - 1]), x0[m]); }
                        f32x4 ua, ub_, ga, gb;
                        ua = (f32x4){bfl(x2[0]), bfh(x2[0]), bfl(x2[1]), bfh(x2[1])}; ub_ = (f32x4){bfl(x2[2]), bfh(x2[2]), bfl(x2[3]), bfh(x2[3])};
                        if (ai == 0 && m == 0) { const float k2 = lrow0 >= 2 ? 1.f : 0.f; ua = ua * k2; ub_ = ub_ * k2; }
                        ga = w0a * ua; gb = w0b * ub_;
                        ua = (f32x4){bfl(x1[0]), bfh(x1[0]), bfl(x1[1]), bfh(x1[1])}; ub_ = (f32x4){bfl(x1[2]), bfh(x1[2]), bfl(x1[3]), bfh(x1[3])};
                        if (ai == 0 && m == 0) { const float k1 = lrow0 >= 1 ? 1.f : 0.f; ua = ua * k1; ub_ = ub_ * k1; }
                        ga = ga + w1a * ua; gb = gb + w1b * ub_;
                        ua = (f32x4){bfl(x0[m][0]), bfh(x0[m][0]), bfl(x0[m][1]), bfh(x0[m][1])}; ub_ = (f32x4){bfl(x0[m][2]), bfh(x0[m][2]), bfl(x0[m][3]), bfh(x0[m][3])};
                        ga = (ga + w2a * ua) * ba; gb = (gb + w2b * ub_) * bb;
                        u32x4 w; w.x = cvt_pk(ga[0], ga[1]); w.y = cvt_pk(ga[2], ga[3]); w.z = cvt_pk(gb[0], gb[1]); w.w = cvt_pk(gb[2], gb[3]);
                        *(u32x4*)(gbase + o) = w;
                        if (ai == 0 && m == 0) { if (side && lrow0 < 2) { u32x4 q; q.x = cvt_pk(ba[0], ba[1]); q.y = cvt_pk(ba[2], ba[3]); q.z = cvt_pk(bb[0], bb[1]); q.w = cvt_pk(bb[2], bb[3]);
                            *(u32x4*)(Bs + (size_t)(u.pm * 2 + lrow0) * DM + cb) = q; } }
                    }
                    __builtin_amdgcn_sched_barrier(0);
                }
            }
        }
    }
};
struct TripleOrder {
    int c;
    __device__ bool next(int i, Unit& u) const {
#ifdef PROBE_B4
        if (i > 3 || c >= 256) return false; if (i == 3) i = 2;
#else
        if (i > 2 || c >= 256) return false;
#endif
        const int xcd = c & 7, off = c >> 3, j = off >> 3; u.pm = xcd * 8 + (off & 7);
        u.pn = (i == 2) ? j : 4 + 2 * j + i; return true;
    }
    __device__ __forceinline__ void a_ready(const Unit&) const {}
    __device__ __forceinline__ void done(const Unit&) const {}
};

struct EpiSeam {
    static constexpr bool PERM = true, AFTER_DRAIN = true;
    struct Pre {};
    __device__ __forceinline__ Pre prefetch(const Unit&, int) const { return Pre{}; }
    const float* hin32; const bf16_t* hinb; float* hout32; bf16_t* houtb; const float* gpost; const float* colscale; float* ystat; float* hstat; unsigned* cnt;
    __device__ __forceinline__ void fused(f32x4 (&acc)[2][2][4][2], const Unit& u, int wr, int wc, int fr, int fq, PG8_LAS unsigned char* lds, int wid, int lane) const {
        PG8_LAS float* P = (PG8_LAS float*)lds;
        PG8_LAS float* R = (PG8_LAS float*)(lds + 4096);
        const int tid = wid * 64 + lane;
        const int rowbase = (u.pm & 63) * BM, colbase = u.pn * BM;
        const int lcol = colbase + wc * 32 + 8 * fq;
        if (colscale) {
#pragma unroll
            for (int bj = 0; bj < 2; ++bj)
#pragma unroll
                for (int n = 0; n < 2; ++n) {
                    const f32x4 sc = *(const f32x4*)(colscale + lcol + bj * HALF + 4 * n);
#pragma unroll
                    for (int ai = 0; ai < 2; ++ai)
#pragma unroll
                        for (int m = 0; m < 4; ++m) acc[ai][bj][m][n] = acc[ai][bj][m][n] * sc;
                }
        }
#pragma unroll
        for (int ai = 0; ai < 2; ++ai)
#pragma unroll
            for (int m = 0; m < 4; ++m) {
                float s = 0.f;
#pragma unroll
                for (int bj = 0; bj < 2; ++bj)
#pragma unroll
                    for (int n = 0; n < 2; ++n) { const f32x4 x = acc[ai][bj][m][n]; s += (x[0] * x[0] + x[1] * x[1]) + (x[2] * x[2] + x[3] * x[3]); }
                s += lane_xor(s, lane, 16); s += lane_xor(s, lane, 32);
                if (fq == 0) P[(ai * HALF + wr * 64 + m * 16 + fr) * 4 + wc] = s;
            }
        __syncthreads();
        f32x4 gp[2][2];
#pragma unroll
        for (int bj = 0; bj < 2; ++bj)
#pragma unroll
            for (int n = 0; n < 2; ++n) gp[bj][n] = *(const f32x4*)(gpost + lcol + bj * HALF + 4 * n);
        constexpr int YP = 260;
        PG8_LAS float* Y = (PG8_LAS float*)(lds + 8192);
#define SEAM_STAGE(ai_) do { _Pragma("unroll") for (int m = 0; m < 4; ++m) { const int lr = wr * 64 + m * 16 + fr; \
            _Pragma("unroll") for (int bj = 0; bj < 2; ++bj) _Pragma("unroll") for (int n = 0; n < 2; ++n) \
                *(PG8_LAS f32x4*)(Y + lr * YP + bj * HALF + wc * 32 + 8 * fq + 4 * n) = acc[ai_][bj][m][n] * gp[bj][n]; } } while (0)
        if (tid < 256) __hip_atomic_store(ystat + (size_t)(rowbase + tid) * 4 + u.pn, (P[tid * 4 + 0] + P[tid * 4 + 1]) + (P[tid * 4 + 2] + P[tid * 4 + 3]), __ATOMIC_RELAXED, __HIP_MEMORY_SCOPE_AGENT);
        asm volatile("s_waitcnt vmcnt(0)" ::: "memory");
        unsigned* pc = cnt + 64 * (u.pm & 63);
        if (lane == 0) __hip_atomic_fetch_add(pc, 1u, __ATOMIC_RELAXED, __HIP_MEMORY_SCOPE_AGENT);
        SEAM_STAGE(0);
        if (wid == 0) {
            unsigned spins = 0;
            while ((unsigned)__builtin_amdgcn_readfirstlane(__hip_atomic_load(pc, __ATOMIC_RELAXED, __HIP_MEMORY_SCOPE_AGENT)) < 32u) { __builtin_amdgcn_s_sleep(1); if (++spins > (1u << 24)) break; }
        }
        asm volatile("s_waitcnt vmcnt(0) lgkmcnt(0)" ::: "memory"); __builtin_amdgcn_s_barrier(); asm volatile("" ::: "memory");
        if (tid < 256) {
            const float* sl = ystat + (size_t)(rowbase + tid) * 4;
            const float t0 = __hip_atomic_load(sl + 0, __ATOMIC_RELAXED, __HIP_MEMORY_SCOPE_AGENT), t1 = __hip_atomic_load(sl + 1, __ATOMIC_RELAXED, __HIP_MEMORY_SCOPE_AGENT),
                        t2 = __hip_atomic_load(sl + 2, __ATOMIC_RELAXED, __HIP_MEMORY_SCOPE_AGENT), t3 = __hip_atomic_load(sl + 3, __ATOMIC_RELAXED, __HIP_MEMORY_SCOPE_AGENT);
            R[tid] = rstd_of((f32x4){t0, t1, t2, t3});
        }
        __syncthreads();
#pragma unroll
        for (int ai = 0; ai < 2; ++ai) {
            if (ai == 1) { SEAM_STAGE(1); __syncthreads(); }
#pragma unroll
            for (int kb = 0; kb < 2; ++kb) {
                f32x4 h[8], y[8]; float rr[8];
                const size_t off0 = (size_t)(rowbase + ai * HALF + wid * 16 + kb * 8) * DM + colbase + 4 * lane;
                if (hin32) {
#pragma unroll
                    for (int k = 0; k < 8; ++k) h[k] = *(const f32x4*)(hin32 + off0 + (size_t)k * DM);
                } else {
#pragma unroll
                    for (int k = 0; k < 8; ++k) { const uint2 q = *(const uint2*)(hinb + off0 + (size_t)k * DM); h[k] = (f32x4){bfl(q.x), bfh(q.x), bfl(q.y), bfh(q.y)}; }
                }
#pragma unroll
                for (int k = 0; k < 8; ++k) { const int lr = wid * 16 + kb * 8 + k; y[k] = *(const PG8_LAS f32x4*)(Y + lr * YP + 4 * lane); rr[k] = R[ai * HALF + lr]; }
#pragma unroll
                for (int k = 0; k < 8; ++k) h[k] = h[k] + y[k] * rr[k];
                if (hout32) {
#pragma unroll
                    for (int k = 0; k < 8; ++k) *(f32x4*)(hout32 + off0 + (size_t)k * DM) = h[k];
                } else {
#pragma unroll
                    for (int k = 0; k < 8; ++k) { uint2 w; w.x = cvt_pk(h[k][0], h[k][1]); w.y = cvt_pk(h[k][2], h[k][3]); *(uint2*)(houtb + off0 + (size_t)k * DM) = w; }
                }
                if (hstat) {
                    float sq[8];
#pragma unroll
                    for (int k = 0; k < 8; ++k) sq[k] = (h[k][0] * h[k][0] + h[k][1] * h[k][1]) + (h[k][2] * h[k][2] + h[k][3] * h[k][3]);
#pragma unroll
                    for (int o = 1; o < 64; o <<= 1)
#pragma unroll
                        for (int k = 0; k < 8; ++k) sq[k] += lane_xor(sq[k], lane, o);
                    if (lane == 0) {
#pragma unroll
                        for (int k = 0; k < 8; ++k) hstat[(size_t)(rowbase + ai * HALF + wid * 16 + kb * 8 + k) * 4 + u.pn] = sq[k];
                    }
                }
            }
            __syncthreads();
        }
#undef SEAM_STAGE
    }
};

struct PoolOrder {
    int c;
    __device__ bool next(int i, Unit& u) const { if (i > 0 || c >= 256) return false; u.pm = (c & 3) * 64 + (c >> 2); u.pn = c & 3; return true; }
    __device__ __forceinline__ void a_ready(const Unit&) const {}
    __device__ __forceinline__ void done(const Unit&) const {}
};

template <class Epi, class Sched, bool ALIGN_EPI = false, bool SP2 = false>
__device__ __forceinline__ void gemm_phase(PG8_LAS unsigned char* lds, const Gemm g, const Sched& S, const Epi& E) {
    int tid_ = threadIdx.x; asm volatile("" : "+v"(tid_));
    const unsigned lds_u = (unsigned)(size_t)lds;
    const int tid = tid_, wid = __builtin_amdgcn_readfirstlane(tid >> 6), lane = tid & 63, wr = wid >> 2, wc = wid & 3, fr = lane & 15, fq = lane >> 4;
    const int K = g.K, nt = K / BK;
    unsigned voffA[2], voffB[2];
#pragma unroll
    for (int i = 0; i < 2; ++i) { int R, C; stage_rc(tid * 16 + i * 8192, R, C); const int Rb = Epi::PERM ? ((R & ~31) + perm32(R & 31)) : R;
        voffA[i] = (unsigned)(R * K + C) * 2u; voffB[i] = (unsigned)(Rb * K + C) * 2u; }
    const size_t kstep = (size_t)(BK * 2);
    const size_t hstep = (size_t)HALF * K * 2;
    const size_t tstep = 2 * hstep;
    const unsigned ldsw = (unsigned)wid * 1024u;
    const int aoff = lds_byte(wr * 64 + fr, fq * 8), boff = lds_byte(wc * 32 + fr, fq * 8);
#define PG8_SA(b, h) (((b) * 2 + (h)) * HTB)
#define PG8_SB(b, h) ((4 + (b) * 2 + (h)) * HTB)
#define PG8_STAGE(bufoff, gbase, voff) do { _Pragma("unroll") for (int _i = 0; _i < 2; ++_i) \
        glds16s((const void*)(gbase), (voff)[_i], lds_u + (unsigned)(bufoff) + ldsw + (unsigned)(_i * 8192)); } while (0)
#define PG8_LDA(dst, b, h) do { _Pragma("unroll") for (int m = 0; m < 4; ++m) _Pragma("unroll") for (int k = 0; k < 2; ++k) dst[m][k] = *(const PG8_LAS bf16x8*)(lds + PG8_SA(b, h) + aoff + m * 2048 + k * 1024); } while (0)
#define PG8_LDB(dst, b, h) do { _Pragma("unroll") for (int n = 0; n < 2; ++n) _Pragma("unroll") for (int k = 0; k < 2; ++k) dst[n][k] = *(const PG8_LAS bf16x8*)(lds + PG8_SB(b, h) + boff + n * 2048 + k * 1024); } while (0)
#define PG8_MMA(ai, bj, At, Bt) do { __builtin_amdgcn_s_setprio(1); _Pragma("unroll") for (int m = 0; m < 4; ++m) _Pragma("unroll") for (int n = 0; n < 2; ++n) _Pragma("unroll") for (int k = 0; k < 2; ++k) \
        acc[ai][bj][m][n] = __builtin_amdgcn_mfma_f32_16x16x32_bf16(Bt[n][k], At[m][k], acc[ai][bj][m][n], 0, 0, 0); __builtin_amdgcn_s_setprio(0); } while (0)
#define PG8_WAIT_V(n) asm volatile("s_waitcnt vmcnt(" #n ")" ::: "memory")
#define PG8_WAIT_L(n) asm volatile("s_waitcnt lgkmcnt(" #n ")" ::: "memory")
#define PG8_BAR __builtin_amdgcn_s_barrier()
#define PG8_SCHED __builtin_amdgcn_sched_barrier(0)
    Unit cur, nxt; int ui = 0;
    if (!S.next(0, cur)) return;
    f32x4 acc[2][2][4][2];
#pragma unroll
    for (int a = 0; a < 2; ++a)
#pragma unroll
        for (int b = 0; b < 2; ++b)
#pragma unroll
            for (int m = 0; m < 4; ++m)
#pragma unroll
                for (int n = 0; n < 2; ++n) acc[a][b][m][n] = (f32x4){0.f, 0.f, 0.f, 0.f};
    bf16x8 At[4][2], B0[2][2], B1[2][2];
    const char* cA = (const char*)g.A + (size_t)cur.pm * tstep; const char* cB = (const char*)g.Bt + (size_t)cur.pn * tstep;
    S.a_ready(cur);
    typename Epi::Pre pre = E.prefetch(cur, tid);
    if constexpr (SP2) {
        PG8_STAGE(PG8_SB(0, 0), cB, voffB); PG8_STAGE(PG8_SB(0, 1), cB + hstep, voffB); PG8_STAGE(PG8_SA(0, 0), cA, voffA); PG8_STAGE(PG8_SA(0, 1), cA + hstep, voffA);
        if (wr == 1) PG8_BAR;
        PG8_WAIT_V(2); PG8_BAR;
        PG8_STAGE(PG8_SB(1, 0), cB + kstep, voffB); PG8_STAGE(PG8_SA(1, 0), cA + kstep, voffA); PG8_STAGE(PG8_SB(1, 1), cB + hstep + kstep, voffB);
        PG8_WAIT_V(6); PG8_BAR;
    } else {
        PG8_STAGE(PG8_SB(0, 0), cB, voffB); PG8_STAGE(PG8_SA(0, 0), cA, voffA); PG8_STAGE(PG8_SB(0, 1), cB + hstep, voffB); PG8_STAGE(PG8_SA(0, 1), cA + hstep, voffA);
        if (wr == 1) PG8_BAR;
        PG8_WAIT_V(4); PG8_BAR;
        PG8_STAGE(PG8_SB(1, 0), cB + kstep, voffB); PG8_STAGE(PG8_SA(1, 0), cA + kstep, voffA); PG8_STAGE(PG8_SB(1, 1), cB + hstep + kstep, voffB);
        PG8_WAIT_V(6); PG8_BAR;
    }
    for (;;) {
        const bool has_next = S.next(ui + 1, nxt);
        const char* nA = has_next ? (const char*)g.A + (size_t)nxt.pm * tstep : cA; const char* nB = has_next ? (const char*)g.Bt + (size_t)nxt.pn * tstep : cB;
        for (int t = 0; t < nt; t += 2) {
            const bool last = (t == nt - 2);
            const char* a1 = cA + (size_t)(t + 1) * kstep;
            const char* a2 = last ? nA : cA + (size_t)(t + 2) * kstep; const char* b2 = last ? nB : cB + (size_t)(t + 2) * kstep;
            const char* a3 = a2 + kstep; const char* b3 = b2 + kstep;
            if (last && has_next) S.a_ready(nxt);
            if constexpr (SP2) {
            PG8_LDB(B0, 0, 0); PG8_LDB(B1, 0, 1); PG8_SCHED; PG8_LDA(At, 0, 0); PG8_STAGE(PG8_SA(1, 1), a1 + hstep, voffA);
            PG8_WAIT_V(8); PG8_WAIT_L(0); PG8_BAR; PG8_MMA(0, 0, At, B0); PG8_MMA(0, 1, At, B1); PG8_BAR; PG8_SCHED;
            PG8_LDA(At, 0, 1); PG8_STAGE(PG8_SB(0, 0), b2, voffB); PG8_STAGE(PG8_SB(0, 1), b2 + hstep, voffB); PG8_STAGE(PG8_SA(0, 0), a2, voffA);
            PG8_WAIT_V(8); PG8_WAIT_L(0); PG8_BAR; PG8_MMA(1, 0, At, B0); PG8_MMA(1, 1, At, B1); PG8_BAR; PG8_SCHED;
            PG8_LDB(B0, 1, 0); PG8_LDB(B1, 1, 1); PG8_SCHED; PG8_LDA(At, 1, 0); PG8_STAGE(PG8_SA(0, 1), a2 + hstep, voffA);
            PG8_WAIT_V(8); PG8_WAIT_L(0); PG8_BAR; PG8_MMA(0, 0, At, B0); PG8_MMA(0, 1, At, B1); PG8_BAR; PG8_SCHED;
            PG8_LDA(At, 1, 1); PG8_STAGE(PG8_SB(1, 0), b3, voffB); PG8_STAGE(PG8_SB(1, 1), b3 + hstep, voffB); PG8_STAGE(PG8_SA(1, 0), a3, voffA);
            PG8_WAIT_V(8); PG8_WAIT_L(0); PG8_BAR; PG8_MMA(1, 0, At, B0); PG8_MMA(1, 1, At, B1); PG8_BAR; PG8_SCHED;
            } else {
            PG8_LDB(B0, 0, 0); PG8_SCHED; PG8_LDA(At, 0, 0); PG8_STAGE(PG8_SA(1, 1), a1 + hstep, voffA);
            PG8_WAIT_L(8); PG8_BAR; PG8_WAIT_L(0); PG8_MMA(0, 0, At, B0); PG8_BAR; PG8_SCHED;
            PG8_LDB(B1, 0, 1); PG8_STAGE(PG8_SB(0, 0), b2, voffB);
            PG8_BAR; PG8_WAIT_L(0); PG8_MMA(0, 1, At, B1); PG8_BAR;
            PG8_LDA(At, 0, 1); PG8_STAGE(PG8_SA(0, 0), a2, voffA);
            PG8_BAR; PG8_WAIT_L(0); PG8_MMA(1, 0, At, B0); PG8_BAR; PG8_SCHED;
            PG8_STAGE(PG8_SB(0, 1), b2 + hstep, voffB);
            PG8_WAIT_V(6); PG8_BAR; PG8_MMA(1, 1, At, B1); PG8_BAR;
            PG8_LDB(B0, 1, 0); PG8_SCHED; PG8_LDA(At, 1, 0); PG8_STAGE(PG8_SA(0, 1), a2 + hstep, voffA);
            PG8_WAIT_L(8); PG8_BAR; PG8_WAIT_L(0); PG8_MMA(0, 0, At, B0); PG8_BAR; PG8_SCHED;
            PG8_LDB(B1, 1, 1); PG8_STAGE(PG8_SB(1, 0), b3, voffB);
            PG8_BAR; PG8_WAIT_L(0); PG8_MMA(0, 1, At, B1); PG8_BAR;
            PG8_LDA(At, 1, 1); PG8_STAGE(PG8_SA(1, 0), a3, voffA);
            PG8_BAR; PG8_WAIT_L(0); PG8_MMA(1, 0, At, B0); PG8_BAR; PG8_SCHED;
            PG8_STAGE(PG8_SB(1, 1), b3 + hstep, voffB);
            PG8_WAIT_V(6); PG8_BAR; PG8_MMA(1, 1, At, B1); PG8_BAR;
            }
        }
        if constexpr (ALIGN_EPI) { if (wr == 0) PG8_BAR; }
        if constexpr (!Epi::AFTER_DRAIN) { E(acc, cur, wr, wc, fr, fq, pre, tid); S.done(cur); }
        if (!has_next) break;
#pragma unroll
        for (int a = 0; a < 2; ++a)
#pragma unroll
            for (int b = 0; b < 2; ++b)
#pragma unroll
                for (int m = 0; m < 4; ++m)
#pragma unroll
                    for (int n = 0; n < 2; ++n) acc[a][b][m][n] = (f32x4){0.f, 0.f, 0.f, 0.f};
        cur = nxt; cA = nA; cB = nB; ++ui;
        pre = E.prefetch(cur, tid);
        if constexpr (ALIGN_EPI) { if (wr == 1) PG8_BAR; }
    }
    PG8_WAIT_V(0);
    if constexpr (!ALIGN_EPI) { if (wr == 0) PG8_BAR; }
    PG8_BAR;
    if constexpr (Epi::AFTER_DRAIN) { E.fused(acc, cur, wr, wc, fr, fq, lds, wid, lane); S.done(cur); }
#undef PG8_SA
#undef PG8_SB
#undef PG8_STAGE
#undef PG8_LDA
#undef PG8_LDB
#undef PG8_MMA
#undef PG8_WAIT_V
#undef PG8_WAIT_L
#undef PG8_BAR
#undef PG8_SCHED
}
}

using pg8::bf16_t; using pg8::f32x4; using pg8::u32x4; using pg8::cvt_pk_bf16;
constexpr int M = 16384, D = 1024, FF = 2816, SEQ = 4096;
#ifndef TAIL_N
#define TAIL_N 528
#endif
#ifndef POOL_SP2
#define POOL_SP2 true
#endif
#ifndef GU_SP2
#define GU_SP2 true
#endif
constexpr int LDS_BYTES = 147456;
constexpr size_t MiB = 1u << 20;
constexpr size_t WS_BAR = 0, BAR_BYTES = XCD_BAR_WORDS * 4;
constexpr size_t WS_CNT = 16 * 1024, CNT_BANK_WORDS = 64 * 64;
constexpr size_t ZERO_BYTES = 128 * 1024;
constexpr size_t WS_ZEROS = 120 * 1024;
constexpr size_t WS_YSTAT = 128 * 1024, WS_HSTAT = 384 * 1024;
constexpr size_t WS_BS = 640 * 1024;
constexpr int LDS_MISC = 147456 - 1024, LDS_TAB = 147456 - 2048;
constexpr size_t WS_WPOOL = 1 * MiB, WS_WOUT = 2 * MiB, WS_WIN = 4 * MiB, WS_WGU0 = 10 * MiB, WS_WGU1 = 21 * MiB, WS_WDN0 = 32 * MiB, WS_WDN1 = 38 * MiB;
constexpr size_t WS_AN = 44 * MiB;
constexpr size_t WS_POOLA = 76 * MiB;
constexpr size_t WS_ACT = 108 * MiB;
constexpr size_t WS_END = 196 * MiB;

struct Args { const float* x; const float* gains; const float* pool_w; const float* pool_scale; const float* conv_in_w; const float* conv_w; const float* conv_out_w;
              const float* gu_w; const float* dn_w; float* out; unsigned char* ws; };

__device__ __forceinline__ float wave_sum(float v) {
#pragma unroll
    for (int o = 1; o < 64; o <<= 1) v += __shfl_xor(v, o);
    return v;
}

struct TrItem { const float* W; bf16_t* WT; int K, N, kb, nsrc0, ndst0; const float* gain; };
constexpr int I_POOL = 16, I_GU = 352, I_DN = 176, I_IN = 192, I_OUT = 64, NITEMS = I_POOL + 2 * I_GU + 2 * I_DN + I_IN + I_OUT;
template <int SET> __device__ __forceinline__ bool tr_decode(int vi, const Args& a, TrItem& t) {
    int it;
    if (SET == 0) { if (vi >= I_POOL + I_GU) return false; it = vi; }
    else if (SET == 1) { if (vi >= I_DN + I_IN + I_OUT + I_GU) return false;
        it = vi < I_DN ? I_POOL + 2 * I_GU + vi : (vi < I_DN + I_IN + I_OUT ? I_POOL + 2 * I_GU + 2 * I_DN + (vi - I_DN) : I_POOL + I_GU + (vi - I_DN - I_IN - I_OUT)); }
    else { if (vi >= I_DN) return false; it = I_POOL + 2 * I_GU + I_DN + vi; }
    int r = it; unsigned char* ws = a.ws;
    if (r < I_POOL) { const int g = r >> 2, rb = (r >> 1) & 1; t = TrItem{a.pool_w + (size_t)g * 65536, (bf16_t*)(ws + WS_WPOOL) + (size_t)g * 65536, 256, 256, r & 1, 128 * rb, 128 * rb, nullptr}; return true; } r -= I_POOL;
    if (r < 2 * I_GU) { const int l = r / I_GU; r -= l * I_GU; const int rb = r >> 3, pn = rb >> 1, bj = rb & 1;
        t = TrItem{a.gu_w + (size_t)l * D * 2 * FF, (bf16_t*)(ws + (l ? WS_WGU1 : WS_WGU0)), D, 2 * FF, r & 7, bj * FF + 128 * pn, 128 * rb, a.gains + (l * 4 + 2) * D}; return true; } r -= 2 * I_GU;
    if (r < 2 * I_DN) { const int l = r / I_DN; r -= l * I_DN; const int rb = r / 22;
        t = TrItem{a.dn_w + (size_t)l * FF * D, (bf16_t*)(ws + (l ? WS_WDN1 : WS_WDN0)), FF, D, r % 22, 128 * rb, 128 * rb, nullptr}; return true; } r -= 2 * I_DN;
    if (r < I_IN) { const int rb = r >> 3; int ns;
        if (rb < 8) ns = 128 * rb; else { const int q = (rb - 8) >> 1, bj = (rb - 8) & 1; ns = D + bj * D + 128 * q; }
        t = TrItem{a.conv_in_w, (bf16_t*)(ws + WS_WIN), D, 3 * D, r & 7, ns, 128 * rb, a.gains + 4 * D}; return true; } r -= I_IN;
    { const int rb = r >> 3; t = TrItem{a.conv_out_w, (bf16_t*)(ws + WS_WOUT), D, D, r & 7, 128 * rb, 128 * rb, nullptr}; return true; }
}
__device__ __forceinline__ void tr_load(const TrItem& t, f32x4 (&v)[8], int tid) {
    const int lr = tid >> 5, lc = (tid & 31) * 4;
    const float* p = t.W + (size_t)(t.kb * 128 + 2 * lr) * t.N + t.nsrc0 + lc;
#pragma unroll
    for (int i = 0; i < 4; ++i) { v[2 * i] = __builtin_nontemporal_load((const f32x4*)(p + (size_t)(32 * i) * t.N)); v[2 * i + 1] = __builtin_nontemporal_load((const f32x4*)(p + (size_t)(32 * i + 1) * t.N)); }    if (t.gain) {
        const float* gk = t.gain + t.kb * 128 + 2 * lr;
#pragma unroll
        for (int i = 0; i < 4; ++i) { v[2 * i] = v[2 * i] * gk[32 * i]; v[2 * i + 1] = v[2 * i + 1] * gk[32 * i + 1]; }
    }
}
template <int SET> __device__ __forceinline__ void tr_run(const Args& a, int first, int stride, float* scr_) {
    unsigned* scr = (unsigned*)scr_;
    int tid_ = threadIdx.x; asm volatile("" : "+v"(tid_));
    const int tid = tid_, lr = tid >> 5, lc = (tid & 31) * 4;
    const int c = (tid >> 3) & 15, nb = (tid & 7) + 8 * (tid >> 7);
    TrItem cur, nxt; f32x4 v[8];
    int it = first; bool have = tr_decode<SET>(it, a, cur);
    if (have) tr_load(cur, v, tid);
    while (have) {
#pragma unroll
        for (int i = 0; i < 4; ++i) { unsigned* s = scr + (lr + 16 * i) * 129 + lc;
            s[0] = cvt_pk_bf16(v[2 * i][0], v[2 * i + 1][0]); s[1] = cvt_pk_bf16(v[2 * i][1], v[2 * i + 1][1]); s[2] = cvt_pk_bf16(v[2 * i][2], v[2 * i + 1][2]); s[3] = cvt_pk_bf16(v[2 * i][3], v[2 * i + 1][3]); }
        __syncthreads();
        it += stride; const bool hn = tr_decode<SET>(it, a, nxt);
        if (hn) tr_load(nxt, v, tid);
#pragma unroll
        for (int j = 0; j < 4; ++j) {
            const int n = nb + 32 * j; const unsigned* s = scr + (4 * c) * 129 + n;
            u32x4 o; o.x = s[0]; o.y = s[129]; o.z = s[2 * 129]; o.w = s[3 * 129];
            *(u32x4*)(cur.WT + (size_t)(cur.ndst0 + n) * cur.K + cur.kb * 128 + 8 * c) = o;
        }
        __syncthreads();
        cur = nxt; have = hn;
    }
}

__device__ __forceinline__ void pool_prep_chunk(const float* __restrict__ x, const float* __restrict__ g0, bf16_t* __restrict__ poolA, int chunk, float* HN) {
    int tid_ = threadIdx.x; asm volatile("" : "+v"(tid_));
    const int tid = tid_, lane = tid & 63, wave = tid >> 6;
    const int t0 = chunk * 64, p0 = t0 & (SEQ - 1);
    const bool halo = p0 > 0;
    const int cq = tid & 255, hh = tid >> 8, g = cq >> 6, w = 2 << g;
    bf16_t* opb = poolA + ((size_t)g * M + t0) * 256 + ((4 * cq) & 255);
    f32x4 g0v[4];
#pragma unroll
    for (int j = 0; j < 4; ++j) g0v[j] = *(const f32x4*)(g0 + 4 * lane + 256 * j);
    f32x4 rv[2][2][4];
#define PP_ISSUE(blk) do { _Pragma("unroll") for (int q = 0; q < 2; ++q) { const f32x4* xr = (const f32x4*)(x + (size_t)(t0 + 16 * ((blk) - 1) + 2 * wave + q) * D) + lane; \
        _Pragma("unroll") for (int j = 0; j < 4; ++j) rv[(blk) & 1][q][j] = xr[64 * j]; } } while (0)
    if (halo) PP_ISSUE(0);
    else {
#pragma unroll
        for (int q = 0; q < 2; ++q)
#pragma unroll
            for (int j = 0; j < 4; ++j) rv[0][q][j] = (f32x4){0.f, 0.f, 0.f, 0.f};
    }
    PP_ISSUE(1);
#pragma unroll
    for (int b = 0; b < 5; ++b) {
        const int slot = b & 1;
#pragma unroll
        for (int q = 0; q < 2; ++q) {
            float s = 0.f;
#pragma unroll
            for (int j = 0; j < 4; ++j) { const f32x4 v = rv[b & 1][q][j]; s += (v[0] * v[0] + v[1] * v[1]) + (v[2] * v[2] + v[3] * v[3]); }
            s = wave_sum(s);
            const float rs = rsqrtf(s * (1.0f / D) + 1e-6f);
#pragma unroll
            for (int j = 0; j < 4; ++j) *(f32x4*)(HN + (slot * 16 + 2 * wave + q) * 1024 + 4 * lane + 256 * j) = rv[b & 1][q][j] * rs * g0v[j];
        }
        if (b < 3) PP_ISSUE(b + 2);
        __syncthreads();
        if (b >= 1) {
            const float* Xc = HN + slot * 16 * 1024 + 4 * cq; const float* Xp = HN + (slot ^ 1) * 16 * 1024 + 4 * cq;
            const int r0 = 8 * hh, pbase = p0 + 16 * (b - 1) + r0;
#define PP_ROW(r_) (*(const f32x4*)(((r_) < 0 ? Xp : Xc) + ((r_) & 15) * 1024))
            f32x4 s = {0.f, 0.f, 0.f, 0.f};
#pragma unroll
            for (int q = 15; q >= 1; --q) { const float wq = (q < w) ? 1.f : 0.f; s += PP_ROW(r0 - q) * wq; }
#pragma unroll
            for (int i = 0; i < 8; ++i) {
                const int p = pbase + i;
                const f32x4 cur = PP_ROW(r0 + i);
                const f32x4 win = s + cur;
                const float inv = 1.0f / (float)((p + 1 < w) ? p + 1 : w);
                const f32x4 o = win * inv - cur;
                uint2 pk; pk.x = cvt_pk_bf16(o[0], o[1]); pk.y = cvt_pk_bf16(o[2], o[3]);
                *(uint2*)(opb + (size_t)(16 * (b - 1) + r0 + i) * 256) = pk;
                const int ro = r0 + i - w + 1;
                s = win - PP_ROW(ro);
            }
#undef PP_ROW
        }
        __syncthreads();
        __builtin_amdgcn_sched_barrier(0);
    }
#undef PP_ISSUE
}

__device__ __forceinline__ float bf_lo(unsigned w) { return __builtin_bit_cast(float, w << 16); }
__device__ __forceinline__ float bf_hi(unsigned w) { return __builtin_bit_cast(float, w & 0xffff0000u); }

__device__ __forceinline__ void conv_patch(const bf16_t* __restrict__ Bs, const bf16_t* __restrict__ Ub, const float* __restrict__ taps, bf16_t* __restrict__ G, int pm) {
    int tid_ = threadIdx.x; asm volatile("" : "+v"(tid_));
    if (pm & 15) {
        const int r = tid_ >> 8, c4 = (tid_ & 255) * 4; const size_t t = (size_t)pm * 256 + r;
        const uint2 b = *(const uint2*)(Bs + (size_t)(pm * 2 + r) * D + c4);
        const uint2 x0 = *(const uint2*)(Ub + t * pg8::UPITCH + c4), x1 = *(const uint2*)(Ub + (t - 1) * pg8::UPITCH + c4), x2 = *(const uint2*)(Ub + (t - 2) * pg8::UPITCH + c4);
        const f32x4 w0 = *(const f32x4*)(taps + c4), w1 = *(const f32x4*)(taps + D + c4), w2 = *(const f32x4*)(taps + 2 * D + c4);
        const f32x4 u0 = {bf_lo(x0.x), bf_hi(x0.x), bf_lo(x0.y), bf_hi(x0.y)}, u1 = {bf_lo(x1.x), bf_hi(x1.x), bf_lo(x1.y), bf_hi(x1.y)}, u2 = {bf_lo(x2.x), bf_hi(x2.x), bf_lo(x2.y), bf_hi(x2.y)};
        const f32x4 bv = {bf_lo(b.x), bf_hi(b.x), bf_lo(b.y), bf_hi(b.y)};
        const f32x4 g = ((w0 * u2 + w1 * u1) + w2 * u0) * bv;
        uint2 o; o.x = cvt_pk_bf16(g[0], g[1]); o.y = cvt_pk_bf16(g[2], g[3]);
        *(uint2*)(G + t * D + c4) = o;
    }
    asm volatile("s_waitcnt vmcnt(0)" ::: "memory");
    __syncthreads();
}

__global__ void __launch_bounds__(512, 2) fwd_megakernel(Args a) {
    extern __shared__ __attribute__((aligned(16))) unsigned char lds_raw[];
    LAS unsigned char* lds = (LAS unsigned char*)lds_raw;
    cg::grid_group grid = cg::this_grid();
    if (threadIdx.x < 2) ((volatile LAS unsigned*)(lds + LDS_MISC))[threadIdx.x] = 0u;
    __syncthreads();
    const XcdBarrier xbar = xcd_barrier_post((unsigned*)(a.ws + WS_BAR), (volatile LAS unsigned*)(lds + LDS_MISC));
    const int bid = blockIdx.x, G = gridDim.x;
    unsigned char* ws = a.ws;
    unsigned* cntw = (unsigned*)(ws + WS_CNT);
    float* ystat = (float*)(ws + WS_YSTAT); float* hstat = (float*)(ws + WS_HSTAT);
    bf16_t* Wpool = (bf16_t*)(ws + WS_WPOOL); bf16_t* Wout = (bf16_t*)(ws + WS_WOUT); bf16_t* Win = (bf16_t*)(ws + WS_WIN);
    bf16_t* AN = (bf16_t*)(ws + WS_AN); bf16_t* POOLA = (bf16_t*)(ws + WS_POOLA); bf16_t* ACT = (bf16_t*)(ws + WS_ACT);
    bf16_t* UB = (bf16_t*)(ws + WS_ACT + 32 * MiB); bf16_t* GB = POOLA; bf16_t* BS = (bf16_t*)(ws + WS_BS);

#ifndef NO_P0
#ifndef REP_P0
#define REP_P0 1
#endif
    for (int rep_ = 0; rep_ < REP_P0; ++rep_) {
        float* scr = (float*)lds_raw;
#ifndef REP_PREP
#define REP_PREP 1
#endif
        for (int rp_ = 0; rp_ < REP_PREP; ++rp_)
        for (int ch = bid; ch < M / 64; ch += G) pool_prep_chunk(a.x, a.gains, POOLA, ch, (float*)lds_raw);
        tr_run<0>(a, bid, G, scr);
    }
#endif
    if (a.ws == nullptr) grid.sync();
    xcd_barrier(xbar);

#ifndef NO_POOL
#ifndef REP_POOL
#define REP_POOL 1
#endif
#ifndef REP_SYNC
#define REP_SYNC 0
#endif
    for (int rep_ = 0; rep_ < REP_SYNC; ++rep_) xcd_barrier(xbar);
    for (int rep_ = 0; rep_ < REP_POOL; ++rep_) {
        if (rep_) xcd_barrier(xbar);
        pg8::Gemm g{POOLA, Wpool, 4 * M, 256, 256}; pg8::PoolOrder S{bid};
        pg8::EpiSeam E{a.x, nullptr, nullptr, AN, a.gains + 1 * D, a.pool_scale, ystat, hstat, cntw + 0 * CNT_BANK_WORDS};
        pg8::gemm_phase<pg8::EpiSeam, pg8::PoolOrder, false, true>(lds, g, S, E);
    }
    xcd_barrier(xbar);
#endif

#pragma unroll 1
    for (int l = 0; l < 2; ++l) {
#ifndef NO_L1MIX
        if (l == 1) {
#ifndef REP_INPROJ
#define REP_INPROJ 1
#endif
            for (int rep_ = 0; rep_ < REP_INPROJ; ++rep_) {
                pg8::Gemm g{AN, Win, M, 3 * D, D}; pg8::TripleOrder S{bid};
                pg8::EpiInProj E{GB, UB, BS, a.conv_w, hstat, (LAS float*)(lds + LDS_TAB)};
                pg8::gemm_phase<pg8::EpiInProj, pg8::TripleOrder, true, true>(lds, g, S, E);
            }
            xcd_barrier(xbar);
            {
                pg8::Gemm g{GB, Wout, M, D, D}; pg8::StaticOrder S; S.init(M, D, G, bid);
                { pg8::Unit u0; if (S.next(0, u0)) conv_patch(BS, UB, a.conv_w, GB, u0.pm); }
                pg8::EpiSeam E{nullptr, AN, nullptr, AN, a.gains + 5 * D, nullptr, ystat, hstat, cntw + 1 * CNT_BANK_WORDS};
                pg8::gemm_phase<pg8::EpiSeam, pg8::StaticOrder, false, true>(lds, g, S, E);
            }
            xcd_barrier(xbar);
        }
#endif
#ifndef NO_FFN
#ifndef REP_GU
#define REP_GU 1
#endif
        for (int rep_ = 0; rep_ < REP_GU; ++rep_) {
            pg8::Gemm g{AN, (const bf16_t*)(ws + (l ? WS_WGU1 : WS_WGU0)), M, 2 * FF, D}; pg8::StaticOrder S; S.init(M, 2 * FF, G, bid);
            pg8::EpiSwiGLU E{ACT, hstat, (LAS float*)(lds + LDS_TAB)};
            pg8::gemm_phase<pg8::EpiSwiGLU, pg8::StaticOrder, true, GU_SP2>(lds, g, S, E);
        }
        if (bid >= G / 2) { if (l == 0) tr_run<1>(a, bid - G / 2, G - G / 2, (float*)lds_raw); else tr_run<2>(a, bid - G / 2, G - G / 2, (float*)lds_raw); }
        xcd_barrier(xbar);
        {
            pg8::Gemm g{ACT, (const bf16_t*)(ws + (l ? WS_WDN1 : WS_WDN0)), M, D, FF}; pg8::StaticOrder S; S.init(M, D, G, bid);
            pg8::EpiSeam E{nullptr, AN, l ? a.out : nullptr, l ? nullptr : AN, a.gains + (l * 4 + 3) * D, nullptr, ystat, l ? nullptr : hstat, cntw + (2 + l) * CNT_BANK_WORDS};
            pg8::gemm_phase<pg8::EpiSeam, pg8::StaticOrder, false, true>(lds, g, S, E);
        }
#endif
        if (l == 0) xcd_barrier(xbar);
    }
}

extern "C" void kernel_launch(void* const* d_in, const int* in_sizes, int n_in, void* d_out, int out_size, void* d_ws, size_t ws_size, hipStream_t stream) {
    static int grid = 0;
    if (grid == 0) {
        int dev = 0, cus = 0, per_cu = 0;
        (void)hipGetDevice(&dev);
        (void)hipDeviceGetAttribute(&cus, hipDeviceAttributeMultiprocessorCount, dev);
        (void)hipFuncSetAttribute((const void*)fwd_megakernel, hipFuncAttributeMaxDynamicSharedMemorySize, LDS_BYTES);
        (void)hipOccupancyMaxActiveBlocksPerMultiprocessor(&per_cu, (const void*)fwd_megakernel, 512, LDS_BYTES);
        (void)hipGetLastError();
        if (n_in != 9 || out_size != M * D || ws_size < WS_END || cus * (per_cu > 0 ? per_cu : 1) < 256)
            fprintf(stderr, "kernel_launch: unexpected problem/device: n_in %d out %d ws %zu cus %d per_cu %d\n", n_in, out_size, ws_size, cus, per_cu);
        grid = 256;
    }
    (void)hipMemsetAsync((char*)d_ws + WS_BAR, 0, ZERO_BYTES, stream);
    Args a{};
    a.x = (const float*)d_in[0]; a.gains = (const float*)d_in[1]; a.pool_w = (const float*)d_in[2]; a.pool_scale = (const float*)d_in[3];
    a.conv_in_w = (const float*)d_in[4]; a.conv_w = (const float*)d_in[5]; a.conv_out_w = (const float*)d_in[6]; a.gu_w = (const float*)d_in[7]; a.dn_w = (const float*)d_in[8];
    a.out = (float*)d_out; a.ws = (unsigned char*)d_ws;
    void* args[] = {&a};
    const hipError_t e = hipLaunchCooperativeKernel((const void*)fwd_megakernel, dim3(grid), dim3(512), args, LDS_BYTES, stream);
    if (e != hipSuccess) fprintf(stderr, "cooperative launch failed: %s (grid %d)\n", hipGetErrorString(e), grid);
}
```

```cpp
#include <hip/hip_runtime.h>
#include <hip/hip_cooperative_groups.h>
#include <cstdio>
#include <cstdint>
namespace cg = cooperative_groups;

#define LAS __attribute__((address_space(3)))
#define XB_TMO      128
#define XB_XCNT(j)  (256  + 64 * (j))
#define XB_XSUB(j)  (1280 + 64 * (j))
#define XB_XGEN(j)  (2304 + 64 * (j))
#define XB_TOP      3328
#define XB_TOPGEN   3392
#define XCD_BAR_WORDS 3456
#define XB_SPIN_CAP (1u << 18)

__device__ __forceinline__ unsigned xb_ld(unsigned* p)              { return __hip_atomic_load(p, __ATOMIC_RELAXED, __HIP_MEMORY_SCOPE_AGENT); }
__device__ __forceinline__ unsigned xb_add(unsigned* p, unsigned v) { return __hip_atomic_fetch_add(p, v, __ATOMIC_RELAXED, __HIP_MEMORY_SCOPE_AGENT); }
__device__ __forceinline__ unsigned xb_xcc_id() { return (unsigned)__builtin_amdgcn_s_getreg((3 << 11) | 20) & 0xFu; }
#define XB_SPIN(cond, bar) do { unsigned _sp = 0; while (cond) { __builtin_amdgcn_s_sleep(1); \
    if ((++_sp & 255u) == 0u) { if (xb_ld(&(bar)[XB_TMO])) break; if (_sp > XB_SPIN_CAP) { atomicAdd(&(bar)[XB_TMO], 1u); break; } } } } while (0)

struct XcdBarrier {
    unsigned* bar; unsigned x;
    volatile LAS unsigned* st;
};

__device__ __forceinline__ XcdBarrier xcd_barrier_post(unsigned* bar, volatile LAS unsigned* st) {
    XcdBarrier b; b.bar = bar; b.x = xb_xcc_id(); b.st = st;
    if (threadIdx.x == 0) (void)xb_add(&bar[XB_XCNT(b.x)], 1u);
    return b;
}
__device__ __forceinline__ void xcd_barrier_complete(unsigned* bar, unsigned x, unsigned& nloc, unsigned& nx) {
    const unsigned G = gridDim.x * gridDim.y * gridDim.z;
    unsigned sum, cnt, mine, sp = 0u;
    for (;;) {
        sum = 0u; cnt = 0u; mine = 0u;
#pragma unroll
        for (unsigned j = 0; j < 16; ++j) { const unsigned c = xb_ld(&bar[XB_XCNT(j)]); sum += c; cnt += (c > 0u) ? 1u : 0u; mine = (j == x) ? c : mine; }
        if (sum == G) break;
        __builtin_amdgcn_s_sleep(1);
        if ((++sp & 255u) == 0u) { if (xb_ld(&bar[XB_TMO])) break; if (sp > XB_SPIN_CAP) { atomicAdd(&bar[XB_TMO], 1u); break; } }
    }
    nloc = mine > 0u ? mine : 1u; nx = cnt > 0u ? cnt : 1u;
}

__device__ __forceinline__ void xcd_barrier(const XcdBarrier& b) {
    asm volatile("s_waitcnt vmcnt(0)" ::: "memory");
    __syncthreads();
    if (threadIdx.x == 0) {
        unsigned* bar = b.bar; unsigned bx = b.x; asm volatile("" : "+s"(bx));
        __builtin_amdgcn_s_waitcnt(0);
        unsigned nloc = b.st[0], nx = b.st[1];
        if (nloc == 0u) { xcd_barrier_complete(bar, bx, nloc, nx); b.st[0] = nloc; b.st[1] = nx; }
        const unsigned old = xb_add(&bar[XB_XSUB(bx)], 1u);
        const unsigned gen = old / nloc;
        if (old + 1u == (gen + 1u) * nloc) {
            __builtin_amdgcn_fence(__ATOMIC_RELEASE, "agent");
            asm volatile("s_waitcnt vmcnt(0)" ::: "memory");
            const unsigned og = xb_add(&bar[XB_TOP], 1u);
            const unsigned tg = og / nx;
            if (og + 1u == (tg + 1u) * nx) xb_add(&bar[XB_TOPGEN], 1u);
            else XB_SPIN(xb_ld(&bar[XB_TOPGEN]) == tg, bar);
            __builtin_amdgcn_fence(__ATOMIC_ACQUIRE, "agent");
            xb_add(&bar[XB_XGEN(bx)], 1u);
            asm volatile("s_waitcnt vmcnt(0)" ::: "memory");
        } else {
            XB_SPIN(xb_ld(&bar[XB_XGEN(bx)]) == gen, bar);
            __builtin_amdgcn_fence(__ATOMIC_ACQUIRE, "agent");
            asm volatile("s_waitcnt vmcnt(0)" ::: "memory");
        }
    }
    __syncthreads();
}
#ifndef PG8_WGM
#define PG8_WGM 8
#endif
namespace pg8 {
#define PG8_LAS __attribute__((address_space(3)))
typedef unsigned short bf16_t;
typedef short bf16x8 __attribute__((ext_vector_type(8)));
typedef float f32x4 __attribute__((ext_vector_type(4)));
typedef unsigned u32x4 __attribute__((ext_vector_type(4)));
constexpr int BM = 256, BK = 64, HALF = 128, HTB = HALF * BK * 2  , STAGE_BYTES = 8 * HTB, NXCD = 8, WGM = PG8_WGM;

__host__ __device__ __forceinline__ int lds_byte(int r, int c) { const int st = (r >> 4) * 2 + (c >> 5), rr = r & 15, cc = c & 31, ob = rr * 64 + cc * 2; return st * 1024 + (ob ^ (((ob >> 9) & 1) << 5)); }
__host__ __device__ __forceinline__ void stage_rc(int b, int& R, int& C) { const int st = b / 1024, sb = b % 1024, swz = sb ^ (((sb >> 9) & 1) << 5); R = (st >> 1) * 16 + swz / 64; C = (st & 1) * 32 + (swz % 64) / 2; }
__host__ __device__ __forceinline__ int perm32(int rho) { const int n = rho >> 4, i = rho & 15; return 8 * (i >> 2) + 4 * n + (i & 3); }

struct Unit { int pm, pn; };
struct Gemm { const bf16_t* A; const bf16_t* Bt; int M, N, K; };

struct StaticOrder {
    int nM, nN, nwg, G, c;
    __host__ __device__ void init(int M, int N, int G_, int c_) { nM = M / BM; nN = N / BM; nwg = nM * nN; G = G_; c = c_; }
    __host__ __device__ bool next(int i, Unit& u) const {
        const long L = (long)i * G + c; if (L >= nwg) return false;
        int wgid = (int)L; { const int q = nwg / NXCD, r = nwg % NXCD, xcd = wgid % NXCD, off = wgid / NXCD; wgid = (xcd < r ? xcd * (q + 1) : r * (q + 1) + (xcd - r) * q) + off; }
        const int nig = WGM * nN, gid = wgid / nig, fm = gid * WGM, gsz = (nM - fm) < WGM ? (nM - fm) : WGM;
        u.pm = fm + ((wgid % nig) % gsz); u.pn = (wgid % nig) / gsz; return true;
    }
    __device__ __forceinline__ void a_ready(const Unit&) const {}
    __device__ __forceinline__ void done(const Unit&) const {}
};

__device__ __forceinline__ unsigned cvt_pk_bf16(float lo, float hi) { unsigned r; asm volatile("v_cvt_pk_bf16_f32 %0, %1, %2" : "=v"(r) : "v"(lo), "v"(hi)); return r; }
__device__ __forceinline__ void glds16s(const void* sbase, unsigned voff, unsigned lds_dst) { unsigned keep;
    asm volatile("s_mov_b32 %0, m0\n\ts_mov_b32 m0, %3\n\ts_nop 0\n\tglobal_load_lds_dwordx4 %1, %2\n\ts_mov_b32 m0, %0" : "=&s"(keep) : "v"(voff), "s"(sbase), "s"(lds_dst) : "memory"); }
constexpr int MROWS = 16384, DM = 1024, DFF = 2816;
constexpr float RMS_EPS = 1e-6f;
#ifndef BGRP
#define BGRP 2
#endif
#ifndef UB_PITCH
#define UB_PITCH 1024
#endif
constexpr int UPITCH = UB_PITCH;

__device__ __forceinline__ float rstd_of(const f32x4 p) { return rsqrtf(((p[0] + p[1]) + (p[2] + p[3])) * (1.0f / DM) + RMS_EPS); }
__device__ __forceinline__ float row_rstd4(const float* st, int row) { return rstd_of(*(const f32x4*)(st + (size_t)row * 4)); }
__device__ __forceinline__ unsigned cvt_pk(float lo, float hi) { unsigned r; asm("v_cvt_pk_bf16_f32 %0, %1, %2" : "=v"(r) : "v"(lo), "v"(hi)); return r; }
__device__ __forceinline__ void load_rs8(const float* st, int row0, float (&rs)[2][4]) {
    f32x4 p[2][4];
#pragma unroll
    for (int ai = 0; ai < 2; ++ai)
#pragma unroll
        for (int m = 0; m < 4; ++m) p[ai][m] = *(const f32x4*)(st + (size_t)(row0 + ai * HALF + m * 16) * 4);
#pragma unroll
    for (int ai = 0; ai < 2; ++ai)
#pragma unroll
        for (int m = 0; m < 4; ++m) rs[ai][m] = rstd_of(p[ai][m]);
}

__device__ __forceinline__ void table_rs8(PG8_LAS float* T, const f32x4 st, int tid, int lrow0, float (&rs)[2][4]) {
    if (tid < 256) T[tid] = rstd_of(st);
    asm volatile("s_waitcnt lgkmcnt(0)" ::: "memory"); __builtin_amdgcn_s_barrier(); asm volatile("" ::: "memory");
#pragma unroll
    for (int ai = 0; ai < 2; ++ai)
#pragma unroll
        for (int m = 0; m < 4; ++m) rs[ai][m] = T[lrow0 + ai * HALF + m * 16];
}

__device__ __forceinline__ float lane_xor(float v, int lane, int mask) { return __builtin_bit_cast(float, __builtin_amdgcn_ds_bpermute((lane ^ mask) << 2, __builtin_bit_cast(int, v))); }

struct EpiSwiGLU {
    static constexpr bool PERM = true, AFTER_DRAIN = false;
    bf16_t* O; const float* hstat; PG8_LAS float* T;
    struct Pre { f32x4 st; };
    __device__ __forceinline__ Pre prefetch(const Unit& u, int tid) const { Pre p; p.st = (f32x4){1.f, 1.f, 1.f, 1.f}; if (tid < 256) p.st = *(const f32x4*)((const char*)hstat + (unsigned)(u.pm * BM + tid) * 16u); return p; }
    __device__ __forceinline__ void operator()(const f32x4 (&acc)[2][2][4][2], const Unit& u, int wr, int wc, int fr, int fq, const Pre& pre, int tid) const {
        asm volatile("" : "+v"(fr));
        const int row0 = u.pm * BM + wr * 64 + fr, col0 = u.pn * 128 + wc * 32 + 8 * fq;
        const unsigned vo = (unsigned)(row0 * DFF + col0) * 2u; char* obase = (char*)O;
        float rsv[2][4]; table_rs8(T, pre.st, tid, wr * 64 + fr, rsv);
#pragma unroll
        for (int ai = 0; ai < 2; ++ai)
#pragma unroll
            for (int m = 0; m < 4; ++m) {
                const float rs = rsv[ai][m];
                f32x4 o[2];
#pragma unroll
                for (int n = 0; n < 2; ++n) {
                    const f32x4 g = acc[ai][0][m][n] * rs, up = acc[ai][1][m][n] * rs;
                    f32x4 e = g * (-1.4426950408889634f);
                    e[0] = __builtin_amdgcn_exp2f(e[0]); e[1] = __builtin_amdgcn_exp2f(e[1]); e[2] = __builtin_amdgcn_exp2f(e[2]); e[3] = __builtin_amdgcn_exp2f(e[3]);
                    e = e + 1.0f;
                    e[0] = __builtin_amdgcn_rcpf(e[0]); e[1] = __builtin_amdgcn_rcpf(e[1]); e[2] = __builtin_amdgcn_rcpf(e[2]); e[3] = __builtin_amdgcn_rcpf(e[3]);
                    o[n] = (g * e) * up;
                }
                u32x4 w; w.x = cvt_pk(o[0][0], o[0][1]); w.y = cvt_pk(o[0][2], o[0][3]); w.z = cvt_pk(o[1][0], o[1][1]); w.w = cvt_pk(o[1][2], o[1][3]);
                *(u32x4*)(obase + (vo + (unsigned)((ai * HALF + m * 16) * DFF * 2))) = w;
            }
    }
};

__device__ __forceinline__ float bfl(unsigned w) { return __builtin_bit_cast(float, w << 16); }
__device__ __forceinline__ float bfh(unsigned w) { return __builtin_bit_cast(float, w & 0xffff0000u); }
template <int CTRL> __device__ __forceinline__ u32x4 dpp_row_shr(u32x4 old, u32x4 src) {
    u32x4 r;
#pragma unroll
    for (int c = 0; c < 4; ++c) r[c] = (unsigned)__builtin_amdgcn_update_dpp((int)old[c], (int)src[c], CTRL, 0xf, 0xf, false);
    return r;
}
struct EpiInProj {
    static constexpr bool PERM = true, AFTER_DRAIN = false;
    bf16_t* Gb; bf16_t* Ub; bf16_t* Bs; const float* taps; const float* hstat; PG8_LAS float* T;
    struct Pre { f32x4 st; };
    __device__ __forceinline__ Pre prefetch(const Unit& u, int tid) const { Pre p; p.st = (f32x4){1.f, 1.f, 1.f, 1.f}; if (tid < 256) p.st = *(const f32x4*)((const char*)hstat + (unsigned)(u.pm * BM + tid) * 16u); return p; }
    __device__ __forceinline__ void operator()(const f32x4 (&acc)[2][2][4][2], const Unit& u, int wr, int wc, int fr, int fq, const Pre& pre, int tid) const {
        asm volatile("" : "+v"(fr));
        const int lrow0 = wr * 64 + fr, row0 = u.pm * BM + lrow0;
        float rsv[2][4]; table_rs8(T, pre.st, tid, lrow0, rsv);
        if (u.pn >= 4) {
            const int col0 = (u.pn - 4) * 128 + wc * 32 + 8 * fq;
            const unsigned vo = (unsigned)(row0 * UPITCH + col0) * 2u; char* ub = (char*)Ub;
#pragma unroll
            for (int ai = 0; ai < 2; ++ai)
#pragma unroll
                for (int m = 0; m < 4; ++m) {
                    const float rs = rsv[ai][m];
                    const f32x4 v0 = (acc[ai][0][m][0] * rs) * (acc[ai][1][m][0] * rs), v1 = (acc[ai][0][m][1] * rs) * (acc[ai][1][m][1] * rs);
                    u32x4 w; w.x = cvt_pk(v0[0], v0[1]); w.y = cvt_pk(v0[2], v0[3]); w.z = cvt_pk(v1[0], v1[1]); w.w = cvt_pk(v1[2], v1[3]);
                    *(u32x4*)(ub + (vo + (unsigned)((ai * HALF + m * 16) * UPITCH * 2))) = w;
                }
        } else {
            const bool side = (u.pm & 15) != 0;
            const char* ubase = (const char*)Ub; char* gbase = (char*)Gb;
#pragma unroll
            for (int bj = 0; bj < 2; ++bj) {
                const int cb = u.pn * 256 + bj * HALF + wc * 32 + 8 * fq;
                const unsigned vo = (unsigned)(row0 * DM + cb) * 2u;
                const unsigned vu = (unsigned)(row0 * UPITCH + cb) * 2u;
                const f32x4 w0a = *(const f32x4*)(taps + cb), w0b = *(const f32x4*)(taps + cb + 4), w1a = *(const f32x4*)(taps + DM + cb), w1b = *(const f32x4*)(taps + DM + cb + 4),
                            w2a = *(const f32x4*)(taps + 2 * DM + cb), w2b = *(const f32x4*)(taps + 2 * DM + cb + 4);
#pragma unroll
                for (int ai = 0; ai < 2; ++ai) {
                    u32x4 x0[4], b1, b2;
#pragma unroll
                    for (int m = 0; m < 4; ++m) x0[m] = *(const u32x4*)(ubase + (vu + (unsigned)((ai * HALF + m * 16) * UPITCH * 2)));
                    {
                        const unsigned o = vu + (unsigned)((ai * HALF) * UPITCH * 2);
                        unsigned o1 = (fr == 0) ? o - (unsigned)(UPITCH * 2) : o, o2 = (fr < 2) ? o - (unsigned)(2 * UPITCH * 2) : o;
                        if (ai == 0) { o1 = lrow0 >= 1 ? o1 : o; o2 = lrow0 >= 2 ? o2 : o; }
                        b1 = *(const u32x4*)(ubase + o1); b2 = *(const u32x4*)(ubase + o2);
                    }
#pragma unroll
                    for (int m = 0; m < 4; ++m) {
                        const unsigned o = vo + (unsigned)((ai * HALF + m * 16) * DM * 2);
                        const float rs = rsv[ai][m];
                        const f32x4 ba = acc[ai][bj][m][0] * rs, bb = acc[ai][bj][m][1] * rs;
                        u32x4 x1, x2;
                        if (m == 0) { x1 = dpp_row_shr<0x111>(b1, x0[0]); x2 = dpp_row_shr<0x112>(b2, x0[0]); }
                        else { x1 = dpp_row_shr<0x111>(dpp_row_shr<0x121>(x0[m - 1], x0[m - 1]), x0[m]); x2 = dpp_row_shr<0x112>(dpp_row_shr<0x122>(x0[m - 1], x0[m - 1]), x0[m]); }
                        f32x4 ua, ub_, ga, gb;
                        ua = (f32x4){bfl(x2[0]), bfh(x2[0]), bfl(x2[1]), bfh(x2[1])}; ub_ = (f32x4){bfl(x2[2]), bfh(x2[2]), bfl(x2[3]), bfh(x2[3])};
                        if (ai == 0 && m == 0) { const float k2 = lrow0 >= 2 ? 1.f : 0.f; ua = ua * k2; ub_ = ub_ * k2; }
                        ga = w0a * ua; gb = w0b * ub_;
                        ua = (f32x4){bfl(x1[0]), bfh(x1[0]), bfl(x1[1]), bfh(x1[1])}; ub_ = (f32x4){bfl(x1[2]), bfh(x1[2]), bfl(x1[3]), bfh(x1[3])};
                        if (ai == 0 && m == 0) { const float k1 = lrow0 >= 1 ? 1.f : 0.f; ua = ua * k1; ub_ = ub_ * k1; }
                        ga = ga + w1a * ua; gb = gb + w1b * ub_;
                        ua = (f32x4){bfl(x0[m][0]), bfh(x0[m][0]), bfl(x0[m][1]), bfh(x0[m][1])}; ub_ = (f32x4){bfl(x0[m][2]), bfh(x0[m][2]), bfl(x0[m][3]), bfh(x0[m][3])};
                        ga = (ga + w2a * ua) * ba; gb = (gb + w2b * ub_) * bb;
                        u32x4 w; w.x = cvt_pk(ga[0], ga[1]); w.y = cvt_pk(ga[2], ga[3]); w.z = cvt_pk(gb[0], gb[1]); w.w = cvt_pk(gb[2], gb[3]);
                        *(u32x4*)(gbase + o) = w;
                        if (ai == 0 && m == 0) { if (side && lrow0 < 2) { u32x4 q; q.x = cvt_pk(ba[0], ba[1]); q.y = cvt_pk(ba[2], ba[3]); q.z = cvt_pk(bb[0], bb[1]); q.w = cvt_pk(bb[2], bb[3]);
                            *(u32x4*)(Bs + (size_t)(u.pm * 2 + lrow0) * DM + cb) = q; } }
                    }
                    __builtin_amdgcn_sched_barrier(0);
                }
            }
        }
    }
};
struct TripleOrder {
    int c;
    __device__ bool next(int i, Unit& u) const {
#ifdef PROBE_B4
        if (i > 3 || c >= 256) return false; if (i == 3) i = 2;
#else
        if (i > 2 || c >= 256) return false;
#endif
        const int xcd = c & 7, off = c >> 3, j = off >> 3; u.pm = xcd * 8 + (off & 7);
        u.pn = (i == 2) ? j : 4 + 2 * j + i; return true;
    }
    __device__ __forceinline__ void a_ready(const Unit&) const {}
    __device__ __forceinline__ void done(const Unit&) const {}
};

struct EpiSeam {
    static constexpr bool PERM = true, AFTER_DRAIN = true;
    struct Pre {};
    __device__ __forceinline__ Pre prefetch(const Unit&, int) const { return Pre{}; }
    const float* hin32; const bf16_t* hinb; float* hout32; bf16_t* houtb; const float* gpost; const float* colscale; float* ystat; float* hstat; unsigned* cnt;
    __device__ __forceinline__ void fused(f32x4 (&acc)[2][2][4][2], const Unit& u, int wr, int wc, int fr, int fq, PG8_LAS unsigned char* lds, int wid, int lane) const {
        PG8_LAS float* P = (PG8_LAS float*)lds;
        PG8_LAS float* R = (PG8_LAS float*)(lds + 4096);
        const int tid = wid * 64 + lane;
        const int rowbase = (u.pm & 63) * BM, colbase = u.pn * BM;
        const int lcol = colbase + wc * 32 + 8 * fq;
        if (colscale) {
#pragma unroll
            for (int bj = 0; bj < 2; ++bj)
#pragma unroll
                for (int n = 0; n < 2; ++n) {
                    const f32x4 sc = *(const f32x4*)(colscale + lcol + bj * HALF + 4 * n);
#pragma unroll
                    for (int ai = 0; ai < 2; ++ai)
#pragma unroll
                        for (int m = 0; m < 4; ++m) acc[ai][bj][m][n] = acc[ai][bj][m][n] * sc;
                }
        }
#pragma unroll
        for (int ai = 0; ai < 2; ++ai)
#pragma unroll
            for (int m = 0; m < 4; ++m) {
                float s = 0.f;
#pragma unroll
                for (int bj = 0; bj < 2; ++bj)
#pragma unroll
                    for (int n = 0; n < 2; ++n) { const f32x4 x = acc[ai][bj][m][n]; s += (x[0] * x[0] + x[1] * x[1]) + (x[2] * x[2] + x[3] * x[3]); }
                s += lane_xor(s, lane, 16); s += lane_xor(s, lane, 32);
                if (fq == 0) P[(ai * HALF + wr * 64 + m * 16 + fr) * 4 + wc] = s;
            }
        __syncthreads();
        f32x4 gp[2][2];
#pragma unroll
        for (int bj = 0; bj < 2; ++bj)
#pragma unroll
            for (int n = 0; n < 2; ++n) gp[bj][n] = *(const f32x4*)(gpost + lcol + bj * HALF + 4 * n);
        constexpr int YP = 260;
        PG8_LAS float* Y = (PG8_LAS float*)(lds + 8192);
#define SEAM_STAGE(ai_) do { _Pragma("unroll") for (int m = 0; m < 4; ++m) { const int lr = wr * 64 + m * 16 + fr; \
            _Pragma("unroll") for (int bj = 0; bj < 2; ++bj) _Pragma("unroll") for (int n = 0; n < 2; ++n) \
                *(PG8_LAS f32x4*)(Y + lr * YP + bj * HALF + wc * 32 + 8 * fq + 4 * n) = acc[ai_][bj][m][n] * gp[bj][n]; } } while (0)
        uint2 hq[8];
#define SEAM_HQ(ai_, kb_) do { const size_t o_ = (size_t)(rowbase + (ai_) * HALF + wid * 16 + (kb_) * 8) * DM + colbase + 4 * lane; \
            _Pragma("unroll") for (int k = 0; k < 8; ++k) hq[k] = *(const uint2*)(hinb + o_ + (size_t)k * DM); } while (0)
        if (!hin32) SEAM_HQ(0, 0);
        if (tid < 256) __hip_atomic_store(ystat + (size_t)(rowbase + tid) * 4 + u.pn, (P[tid * 4 + 0] + P[tid * 4 + 1]) + (P[tid * 4 + 2] + P[tid * 4 + 3]), __ATOMIC_RELAXED, __HIP_MEMORY_SCOPE_AGENT);
        asm volatile("s_waitcnt vmcnt(0)" ::: "memory");
        unsigned* pc = cnt + 64 * (u.pm & 63);
        if (lane == 0) __hip_atomic_fetch_add(pc, 1u, __ATOMIC_RELAXED, __HIP_MEMORY_SCOPE_AGENT);
        SEAM_STAGE(0);
        if (wid == 0) {
            unsigned spins = 0;
            while ((unsigned)__builtin_amdgcn_readfirstlane(__hip_atomic_load(pc, __ATOMIC_RELAXED, __HIP_MEMORY_SCOPE_AGENT)) < 32u) { __builtin_amdgcn_s_sleep(1); if (++spins > (1u << 24)) break; }
        }
        asm volatile("s_waitcnt vmcnt(0) lgkmcnt(0)" ::: "memory"); __builtin_amdgcn_s_barrier(); asm volatile("" ::: "memory");
        if (tid < 256) {
            const float* sl = ystat + (size_t)(rowbase + tid) * 4;
            const float t0 = __hip_atomic_load(sl + 0, __ATOMIC_RELAXED, __HIP_MEMORY_SCOPE_AGENT), t1 = __hip_atomic_load(sl + 1, __ATOMIC_RELAXED, __HIP_MEMORY_SCOPE_AGENT),
                        t2 = __hip_atomic_load(sl + 2, __ATOMIC_RELAXED, __HIP_MEMORY_SCOPE_AGENT), t3 = __hip_atomic_load(sl + 3, __ATOMIC_RELAXED, __HIP_MEMORY_SCOPE_AGENT);
            R[tid] = rstd_of((f32x4){t0, t1, t2, t3});
        }
        __syncthreads();
#pragma unroll
        for (int ai = 0; ai < 2; ++ai) {
            if (ai == 1) { SEAM_STAGE(1); __syncthreads(); }
#pragma unroll
            for (int kb = 0; kb < 2; ++kb) {
                f32x4 h[8], y[8]; float rr[8];
                const size_t off0 = (size_t)(rowbase + ai * HALF + wid * 16 + kb * 8) * DM + colbase + 4 * lane;
                if (hin32) {
#pragma unroll
                    for (int k = 0; k < 8; ++k) h[k] = *(const f32x4*)(hin32 + off0 + (size_t)k * DM);
                } else {
#pragma unroll
                    for (int k = 0; k < 8; ++k) h[k] = (f32x4){bfl(hq[k].x), bfh(hq[k].x), bfl(hq[k].y), bfh(hq[k].y)};
                    if (!(ai == 1 && kb == 1)) SEAM_HQ(kb == 0 ? ai : ai + 1, kb == 0 ? 1 : 0);
                }
#pragma unroll
                for (int k = 0; k < 8; ++k) { const int lr = wid * 16 + kb * 8 + k; y[k] = *(const PG8_LAS f32x4*)(Y + lr * YP + 4 * lane); rr[k] = R[ai * HALF + lr]; }
#pragma unroll
                for (int k = 0; k < 8; ++k) h[k] = h[k] + y[k] * rr[k];
                if (hout32) {
#pragma unroll
                    for (int k = 0; k < 8; ++k) *(f32x4*)(hout32 + off0 + (size_t)k * DM) = h[k];
                } else {
#pragma unroll
                    for (int k = 0; k < 8; ++k) { uint2 w; w.x = cvt_pk(h[k][0], h[k][1]); w.y = cvt_pk(h[k][2], h[k][3]); *(uint2*)(houtb + off0 + (size_t)k * DM) = w; }
                }
                if (hstat) {
                    float sq[8];
#pragma unroll
                    for (int k = 0; k < 8; ++k) sq[k] = (h[k][0] * h[k][0] + h[k][1] * h[k][1]) + (h[k][2] * h[k][2] + h[k][3] * h[k][3]);
#pragma unroll
                    for (int o = 1; o < 64; o <<= 1)
#pragma unroll
                        for (int k = 0; k < 8; ++k) sq[k] += lane_xor(sq[k], lane, o);
                    if (lane == 0) {
#pragma unroll
                        for (int k = 0; k < 8; ++k) hstat[(size_t)(rowbase + ai * HALF + wid * 16 + kb * 8 + k) * 4 + u.pn] = sq[k];
                    }
                }
            }
            __syncthreads();
        }
#undef SEAM_STAGE
#undef SEAM_HQ
    }
};

struct PoolOrder {
    int c;
    __device__ bool next(int i, Unit& u) const { if (i > 0 || c >= 256) return false; u.pm = (c & 3) * 64 + (c >> 2); u.pn = c & 3; return true; }
    __device__ __forceinline__ void a_ready(const Unit&) const {}
    __device__ __forceinline__ void done(const Unit&) const {}
};

template <class Epi, class Sched, bool ALIGN_EPI = false, bool SP2 = false>
__device__ __forceinline__ void gemm_phase(PG8_LAS unsigned char* lds, const Gemm g, const Sched& S, const Epi& E) {
    int tid_ = threadIdx.x; asm volatile("" : "+v"(tid_));
    const unsigned lds_u = (unsigned)(size_t)lds;
    const int tid = tid_, wid = __builtin_amdgcn_readfirstlane(tid >> 6), lane = tid & 63, wr = wid >> 2, wc = wid & 3, fr = lane & 15, fq = lane >> 4;
    const int K = g.K, nt = K / BK;
    unsigned voffA[2], voffB[2];
#pragma unroll
    for (int i = 0; i < 2; ++i) { int R, C; stage_rc(tid * 16 + i * 8192, R, C); const int Rb = Epi::PERM ? ((R & ~31) + perm32(R & 31)) : R;
        voffA[i] = (unsigned)(R * K + C) * 2u; voffB[i] = (unsigned)(Rb * K + C) * 2u; }
    const size_t kstep = (size_t)(BK * 2);
    const size_t hstep = (size_t)HALF * K * 2;
    const size_t tstep = 2 * hstep;
    const unsigned ldsw = (unsigned)wid * 1024u;
    const int aoff = lds_byte(wr * 64 + fr, fq * 8), boff = lds_byte(wc * 32 + fr, fq * 8);
#define PG8_SA(b, h) (((b) * 2 + (h)) * HTB)
#define PG8_SB(b, h) ((4 + (b) * 2 + (h)) * HTB)
#define PG8_STAGE(bufoff, gbase, voff) do { _Pragma("unroll") for (int _i = 0; _i < 2; ++_i) \
        glds16s((const void*)(gbase), (voff)[_i], lds_u + (unsigned)(bufoff) + ldsw + (unsigned)(_i * 8192)); } while (0)
#define PG8_LDA(dst, b, h) do { _Pragma("unroll") for (int m = 0; m < 4; ++m) _Pragma("unroll") for (int k = 0; k < 2; ++k) dst[m][k] = *(const PG8_LAS bf16x8*)(lds + PG8_SA(b, h) + aoff + m * 2048 + k * 1024); } while (0)
#define PG8_LDB(dst, b, h) do { _Pragma("unroll") for (int n = 0; n < 2; ++n) _Pragma("unroll") for (int k = 0; k < 2; ++k) dst[n][k] = *(const PG8_LAS bf16x8*)(lds + PG8_SB(b, h) + boff + n * 2048 + k * 1024); } while (0)
#define PG8_MMA(ai, bj, At, Bt) do { __builtin_amdgcn_s_setprio(1); _Pragma("unroll") for (int m = 0; m < 4; ++m) _Pragma("unroll") for (int n = 0; n < 2; ++n) _Pragma("unroll") for (int k = 0; k < 2; ++k) \
        acc[ai][bj][m][n] = __builtin_amdgcn_mfma_f32_16x16x32_bf16(Bt[n][k], At[m][k], acc[ai][bj][m][n], 0, 0, 0); __builtin_amdgcn_s_setprio(0); } while (0)
#define PG8_WAIT_V(n) asm volatile("s_waitcnt vmcnt(" #n ")" ::: "memory")
#define PG8_WAIT_L(n) asm volatile("s_waitcnt lgkmcnt(" #n ")" ::: "memory")
#define PG8_BAR __builtin_amdgcn_s_barrier()
#define PG8_SCHED __builtin_amdgcn_sched_barrier(0)
    Unit cur, nxt; int ui = 0;
    if (!S.next(0, cur)) return;
    f32x4 acc[2][2][4][2];
#pragma unroll
    for (int a = 0; a < 2; ++a)
#pragma unroll
        for (int b = 0; b < 2; ++b)
#pragma unroll
            for (int m = 0; m < 4; ++m)
#pragma unroll
                for (int n = 0; n < 2; ++n) acc[a][b][m][n] = (f32x4){0.f, 0.f, 0.f, 0.f};
    bf16x8 At[4][2], B0[2][2], B1[2][2];
    const char* cA = (const char*)g.A + (size_t)cur.pm * tstep; const char* cB = (const char*)g.Bt + (size_t)cur.pn * tstep;
    S.a_ready(cur);
    typename Epi::Pre pre = E.prefetch(cur, tid);
    if constexpr (SP2) {
        PG8_STAGE(PG8_SB(0, 0), cB, voffB); PG8_STAGE(PG8_SB(0, 1), cB + hstep, voffB); PG8_STAGE(PG8_SA(0, 0), cA, voffA); PG8_STAGE(PG8_SA(0, 1), cA + hstep, voffA);
        if (wr == 1) PG8_BAR;
        PG8_WAIT_V(2); PG8_BAR;
        PG8_STAGE(PG8_SB(1, 0), cB + kstep, voffB); PG8_STAGE(PG8_SA(1, 0), cA + kstep, voffA); PG8_STAGE(PG8_SB(1, 1), cB + hstep + kstep, voffB);
        PG8_WAIT_V(6); PG8_BAR;
    } else {
        PG8_STAGE(PG8_SB(0, 0), cB, voffB); PG8_STAGE(PG8_SA(0, 0), cA, voffA); PG8_STAGE(PG8_SB(0, 1), cB + hstep, voffB); PG8_STAGE(PG8_SA(0, 1), cA + hstep, voffA);
        if (wr == 1) PG8_BAR;
        PG8_WAIT_V(4); PG8_BAR;
        PG8_STAGE(PG8_SB(1, 0), cB + kstep, voffB); PG8_STAGE(PG8_SA(1, 0), cA + kstep, voffA); PG8_STAGE(PG8_SB(1, 1), cB + hstep + kstep, voffB);
        PG8_WAIT_V(6); PG8_BAR;
    }
    for (;;) {
        const bool has_next = S.next(ui + 1, nxt);
        const char* nA = has_next ? (const char*)g.A + (size_t)nxt.pm * tstep : cA; const char* nB = has_next ? (const char*)g.Bt + (size_t)nxt.pn * tstep : cB;
        for (int t = 0; t < nt; t += 2) {
            const bool last = (t == nt - 2);
            const char* a1 = cA + (size_t)(t + 1) * kstep;
            const char* a2 = last ? nA : cA + (size_t)(t + 2) * kstep; const char* b2 = last ? nB : cB + (size_t)(t + 2) * kstep;
            const char* a3 = a2 + kstep; const char* b3 = b2 + kstep;
            if (last && has_next) S.a_ready(nxt);
            if constexpr (SP2) {
            PG8_LDB(B0, 0, 0); PG8_LDB(B1, 0, 1); PG8_SCHED; PG8_LDA(At, 0, 0); PG8_STAGE(PG8_SA(1, 1), a1 + hstep, voffA);
            PG8_WAIT_V(8); PG8_WAIT_L(0); PG8_BAR; PG8_MMA(0, 0, At, B0); PG8_MMA(0, 1, At, B1); PG8_BAR; PG8_SCHED;
            PG8_LDA(At, 0, 1); PG8_STAGE(PG8_SB(0, 0), b2, voffB); PG8_STAGE(PG8_SB(0, 1), b2 + hstep, voffB); PG8_STAGE(PG8_SA(0, 0), a2, voffA);
            PG8_WAIT_V(8); PG8_WAIT_L(0); PG8_BAR; PG8_MMA(1, 0, At, B0); PG8_MMA(1, 1, At, B1); PG8_BAR; PG8_SCHED;
            PG8_LDB(B0, 1, 0); PG8_LDB(B1, 1, 1); PG8_SCHED; PG8_LDA(At, 1, 0); PG8_STAGE(PG8_SA(0, 1), a2 + hstep, voffA);
            PG8_WAIT_V(8); PG8_WAIT_L(0); PG8_BAR; PG8_MMA(0, 0, At, B0); PG8_MMA(0, 1, At, B1); PG8_BAR; PG8_SCHED;
            PG8_LDA(At, 1, 1); PG8_STAGE(PG8_SB(1, 0), b3, voffB); PG8_STAGE(PG8_SB(1, 1), b3 + hstep, voffB); PG8_STAGE(PG8_SA(1, 0), a3, voffA);
            PG8_WAIT_V(8); PG8_WAIT_L(0); PG8_BAR; PG8_MMA(1, 0, At, B0); PG8_MMA(1, 1, At, B1); PG8_BAR; PG8_SCHED;
            } else {
            PG8_LDB(B0, 0, 0); PG8_SCHED; PG8_LDA(At, 0, 0); PG8_STAGE(PG8_SA(1, 1), a1 + hstep, voffA);
            PG8_WAIT_L(8); PG8_BAR; PG8_WAIT_L(0); PG8_MMA(0, 0, At, B0); PG8_BAR; PG8_SCHED;
            PG8_LDB(B1, 0, 1); PG8_STAGE(PG8_SB(0, 0), b2, voffB);
            PG8_BAR; PG8_WAIT_L(0); PG8_MMA(0, 1, At, B1); PG8_BAR;
            PG8_LDA(At, 0, 1); PG8_STAGE(PG8_SA(0, 0), a2, voffA);
            PG8_BAR; PG8_WAIT_L(0); PG8_MMA(1, 0, At, B0); PG8_BAR; PG8_SCHED;
            PG8_STAGE(PG8_SB(0, 1), b2 + hstep, voffB);
            PG8_WAIT_V(6); PG8_BAR; PG8_MMA(1, 1, At, B1); PG8_BAR;
            PG8_LDB(B0, 1, 0); PG8_SCHED; PG8_LDA(At, 1, 0); PG8_STAGE(PG8_SA(0, 1), a2 + hstep, voffA);
            PG8_WAIT_L(8); PG8_BAR; PG8_WAIT_L(0); PG8_MMA(0, 0, At, B0); PG8_BAR; PG8_SCHED;
            PG8_LDB(B1, 1, 1); PG8_STAGE(PG8_SB(1, 0), b3, voffB);
            PG8_BAR; PG8_WAIT_L(0); PG8_MMA(0, 1, At, B1); PG8_BAR;
            PG8_LDA(At, 1, 1); PG8_STAGE(PG8_SA(1, 0), a3, voffA);
            PG8_BAR; PG8_WAIT_L(0); PG8_MMA(1, 0, At, B0); PG8_BAR; PG8_SCHED;
            PG8_STAGE(PG8_SB(1, 1), b3 + hstep, voffB);
            PG8_WAIT_V(6); PG8_BAR; PG8_MMA(1, 1, At, B1); PG8_BAR;
            }
        }
        if constexpr (ALIGN_EPI) { if (wr == 0) PG8_BAR; }
        if constexpr (!Epi::AFTER_DRAIN) { E(acc, cur, wr, wc, fr, fq, pre, tid); S.done(cur); }
        if (!has_next) break;
#pragma unroll
        for (int a = 0; a < 2; ++a)
#pragma unroll
            for (int b = 0; b < 2; ++b)
#pragma unroll
                for (int m = 0; m < 4; ++m)
#pragma unroll
                    for (int n = 0; n < 2; ++n) acc[a][b][m][n] = (f32x4){0.f, 0.f, 0.f, 0.f};
        cur = nxt; cA = nA; cB = nB; ++ui;
        pre = E.prefetch(cur, tid);
        if constexpr (ALIGN_EPI) { if (wr == 1) PG8_BAR; }
    }
    PG8_WAIT_V(0);
    if constexpr (!ALIGN_EPI) { if (wr == 0) PG8_BAR; }
    PG8_BAR;
    if constexpr (Epi::AFTER_DRAIN) { E.fused(acc, cur, wr, wc, fr, fq, lds, wid, lane); S.done(cur); }
#undef PG8_SA
#undef PG8_SB
#undef PG8_STAGE
#undef PG8_LDA
#undef PG8_LDB
#undef PG8_MMA
#undef PG8_WAIT_V
#undef PG8_WAIT_L
#undef PG8_BAR
#undef PG8_SCHED
}
}

using pg8::bf16_t; using pg8::f32x4; using pg8::u32x4; using pg8::cvt_pk_bf16;
constexpr int M = 16384, D = 1024, FF = 2816, SEQ = 4096;
#ifndef TAIL_N
#define TAIL_N 528
#endif
#ifndef POOL_SP2
#define POOL_SP2 true
#endif
#ifndef GU_SP2
#define GU_SP2 true
#endif
constexpr int LDS_BYTES = 147456;
constexpr size_t MiB = 1u << 20;
constexpr size_t WS_BAR = 0, BAR_BYTES = XCD_BAR_WORDS * 4;
constexpr size_t WS_CNT = 16 * 1024, CNT_BANK_WORDS = 64 * 64;
constexpr size_t ZERO_BYTES = 128 * 1024;
constexpr size_t WS_ZEROS = 120 * 1024;
constexpr size_t WS_YSTAT = 128 * 1024, WS_HSTAT = 384 * 1024;
constexpr size_t WS_BS = 640 * 1024;
constexpr int LDS_MISC = 147456 - 1024, LDS_TAB = 147456 - 2048;
constexpr size_t WS_WPOOL = 1 * MiB, WS_WOUT = 2 * MiB, WS_WIN = 4 * MiB, WS_WGU0 = 10 * MiB, WS_WGU1 = 21 * MiB, WS_WDN0 = 32 * MiB, WS_WDN1 = 38 * MiB;
constexpr size_t WS_AN = 44 * MiB;
constexpr size_t WS_POOLA = 76 * MiB;
constexpr size_t WS_ACT = 108 * MiB;
constexpr size_t WS_END = 196 * MiB;

struct Args { const float* x; const float* gains; const float* pool_w; const float* pool_scale; const float* conv_in_w; const float* conv_w; const float* conv_out_w;
              const float* gu_w; const float* dn_w; float* out; unsigned char* ws; };

__device__ __forceinline__ float wave_sum(float v) {
#pragma unroll
    for (int o = 1; o < 64; o <<= 1) v += __shfl_xor(v, o);
    return v;
}

struct TrItem { const float* W; bf16_t* WT; int K, N, kb, nsrc0, ndst0; const float* gain; };
constexpr int I_POOL = 16, I_GU = 352, I_DN = 176, I_IN = 192, I_OUT = 64, NITEMS = I_POOL + 2 * I_GU + 2 * I_DN + I_IN + I_OUT;
template <int SET> __device__ __forceinline__ bool tr_decode(int vi, const Args& a, TrItem& t) {
    int it;
    if (SET == 0) { if (vi >= I_POOL + I_GU) return false; it = vi; }
    else if (SET == 1) { if (vi >= I_DN + I_IN + I_OUT + I_GU) return false;
        it = vi < I_DN ? I_POOL + 2 * I_GU + vi : (vi < I_DN + I_IN + I_OUT ? I_POOL + 2 * I_GU + 2 * I_DN + (vi - I_DN) : I_POOL + I_GU + (vi - I_DN - I_IN - I_OUT)); }
    else { if (vi >= I_DN) return false; it = I_POOL + 2 * I_GU + I_DN + vi; }
    int r = it; unsigned char* ws = a.ws;
    if (r < I_POOL) { const int g = r >> 2, rb = (r >> 1) & 1; t = TrItem{a.pool_w + (size_t)g * 65536, (bf16_t*)(ws + WS_WPOOL) + (size_t)g * 65536, 256, 256, r & 1, 128 * rb, 128 * rb, nullptr}; return true; } r -= I_POOL;
    if (r < 2 * I_GU) { const int l = r / I_GU; r -= l * I_GU; const int rb = r >> 3, pn = rb >> 1, bj = rb & 1;
        t = TrItem{a.gu_w + (size_t)l * D * 2 * FF, (bf16_t*)(ws + (l ? WS_WGU1 : WS_WGU0)), D, 2 * FF, r & 7, bj * FF + 128 * pn, 128 * rb, a.gains + (l * 4 + 2) * D}; return true; } r -= 2 * I_GU;
    if (r < 2 * I_DN) { const int l = r / I_DN; r -= l * I_DN; const int rb = r / 22;
        t = TrItem{a.dn_w + (size_t)l * FF * D, (bf16_t*)(ws + (l ? WS_WDN1 : WS_WDN0)), FF, D, r % 22, 128 * rb, 128 * rb, nullptr}; return true; } r -= 2 * I_DN;
    if (r < I_IN) { const int rb = r >> 3; int ns;
        if (rb < 8) ns = 128 * rb; else { const int q = (rb - 8) >> 1, bj = (rb - 8) & 1; ns = D + bj * D + 128 * q; }
        t = TrItem{a.conv_in_w, (bf16_t*)(ws + WS_WIN), D, 3 * D, r & 7, ns, 128 * rb, a.gains + 4 * D}; return true; } r -= I_IN;
    { const int rb = r >> 3; t = TrItem{a.conv_out_w, (bf16_t*)(ws + WS_WOUT), D, D, r & 7, 128 * rb, 128 * rb, nullptr}; return true; }
}
__device__ __forceinline__ void tr_load(const TrItem& t, f32x4 (&v)[8], int tid) {
    const int lr = tid >> 5, lc = (tid & 31) * 4;
    const float* p = t.W + (size_t)(t.kb * 128 + 2 * lr) * t.N + t.nsrc0 + lc;
#pragma unroll
    for (int i = 0; i < 4; ++i) { v[2 * i] = __builtin_nontemporal_load((const f32x4*)(p + (size_t)(32 * i) * t.N)); v[2 * i + 1] = __builtin_nontemporal_load((const f32x4*)(p + (size_t)(32 * i + 1) * t.N)); }    if (t.gain) {
        const float* gk = t.gain + t.kb * 128 + 2 * lr;
#pragma unroll
        for (int i = 0; i < 4; ++i) { v[2 * i] = v[2 * i] * gk[32 * i]; v[2 * i + 1] = v[2 * i + 1] * gk[32 * i + 1]; }
    }
}
template <int SET> __device__ __forceinline__ void tr_run(const Args& a, int first, int stride, float* scr_) {
    unsigned* scr = (unsigned*)scr_;
    int tid_ = threadIdx.x; asm volatile("" : "+v"(tid_));
    const int tid = tid_, lr = tid >> 5, lc = (tid & 31) * 4;
    const int c = (tid >> 3) & 15, nb = (tid & 7) + 8 * (tid >> 7);
    TrItem cur, nxt; f32x4 v[8];
    int it = first; bool have = tr_decode<SET>(it, a, cur);
    if (have) tr_load(cur, v, tid);
    while (have) {
#pragma unroll
        for (int i = 0; i < 4; ++i) { unsigned* s = scr + (lr + 16 * i) * 129 + lc;
            s[0] = cvt_pk_bf16(v[2 * i][0], v[2 * i + 1][0]); s[1] = cvt_pk_bf16(v[2 * i][1], v[2 * i + 1][1]); s[2] = cvt_pk_bf16(v[2 * i][2], v[2 * i + 1][2]); s[3] = cvt_pk_bf16(v[2 * i][3], v[2 * i + 1][3]); }
        __syncthreads();
        it += stride; const bool hn = tr_decode<SET>(it, a, nxt);
        if (hn) tr_load(nxt, v, tid);
#pragma unroll
        for (int j = 0; j < 4; ++j) {
            const int n = nb + 32 * j; const unsigned* s = scr + (4 * c) * 129 + n;
            u32x4 o; o.x = s[0]; o.y = s[129]; o.z = s[2 * 129]; o.w = s[3 * 129];
            *(u32x4*)(cur.WT + (size_t)(cur.ndst0 + n) * cur.K + cur.kb * 128 + 8 * c) = o;
        }
        __syncthreads();
        cur = nxt; have = hn;
    }
}

__device__ __forceinline__ void pool_prep_chunk(const float* __restrict__ x, const float* __restrict__ g0, bf16_t* __restrict__ poolA, int chunk, float* HN) {
    int tid_ = threadIdx.x; asm volatile("" : "+v"(tid_));
    const int tid = tid_, lane = tid & 63, wave = tid >> 6;
    const int t0 = chunk * 64, p0 = t0 & (SEQ - 1);
    const bool halo = p0 > 0;
    const int cq = tid & 255, hh = tid >> 8, g = cq >> 6, w = 2 << g;
    bf16_t* opb = poolA + ((size_t)g * M + t0) * 256 + ((4 * cq) & 255);
    f32x4 g0v[4];
#pragma unroll
    for (int j = 0; j < 4; ++j) g0v[j] = *(const f32x4*)(g0 + 4 * lane + 256 * j);
    f32x4 rv[2][2][4];
#define PP_ISSUE(blk) do { _Pragma("unroll") for (int q = 0; q < 2; ++q) { const f32x4* xr = (const f32x4*)(x + (size_t)(t0 + 16 * ((blk) - 1) + 2 * wave + q) * D) + lane; \
        _Pragma("unroll") for (int j = 0; j < 4; ++j) rv[(blk) & 1][q][j] = xr[64 * j]; } } while (0)
    if (halo) PP_ISSUE(0);
    else {
#pragma unroll
        for (int q = 0; q < 2; ++q)
#pragma unroll
            for (int j = 0; j < 4; ++j) rv[0][q][j] = (f32x4){0.f, 0.f, 0.f, 0.f};
    }
    PP_ISSUE(1);
#pragma unroll
    for (int b = 0; b < 5; ++b) {
        const int slot = b & 1;
#pragma unroll
        for (int q = 0; q < 2; ++q) {
            float s = 0.f;
#pragma unroll
            for (int j = 0; j < 4; ++j) { const f32x4 v = rv[b & 1][q][j]; s += (v[0] * v[0] + v[1] * v[1]) + (v[2] * v[2] + v[3] * v[3]); }
            s = wave_sum(s);
            const float rs = rsqrtf(s * (1.0f / D) + 1e-6f);
#pragma unroll
            for (int j = 0; j < 4; ++j) *(f32x4*)(HN + (slot * 16 + 2 * wave + q) * 1024 + 4 * lane + 256 * j) = rv[b & 1][q][j] * rs * g0v[j];
        }
        if (b < 3) PP_ISSUE(b + 2);
        __syncthreads();
        if (b >= 1) {
            const float* Xc = HN + slot * 16 * 1024 + 4 * cq; const float* Xp = HN + (slot ^ 1) * 16 * 1024 + 4 * cq;
            const int r0 = 8 * hh, pbase = p0 + 16 * (b - 1) + r0;
#define PP_ROW(r_) (*(const f32x4*)(((r_) < 0 ? Xp : Xc) + ((r_) & 15) * 1024))
            f32x4 s = {0.f, 0.f, 0.f, 0.f};
#pragma unroll
            for (int q = 15; q >= 1; --q) { const float wq = (q < w) ? 1.f : 0.f; s += PP_ROW(r0 - q) * wq; }
#pragma unroll
            for (int i = 0; i < 8; ++i) {
                const int p = pbase + i;
                const f32x4 cur = PP_ROW(r0 + i);
                const f32x4 win = s + cur;
                const float inv = 1.0f / (float)((p + 1 < w) ? p + 1 : w);
                const f32x4 o = win * inv - cur;
                uint2 pk; pk.x = cvt_pk_bf16(o[0], o[1]); pk.y = cvt_pk_bf16(o[2], o[3]);
                *(uint2*)(opb + (size_t)(16 * (b - 1) + r0 + i) * 256) = pk;
                const int ro = r0 + i - w + 1;
                s = win - PP_ROW(ro);
            }
#undef PP_ROW
        }
        __syncthreads();
        __builtin_amdgcn_sched_barrier(0);
    }
#undef PP_ISSUE
}

__device__ __forceinline__ float bf_lo(unsigned w) { return __builtin_bit_cast(float, w << 16); }
__device__ __forceinline__ float bf_hi(unsigned w) { return __builtin_bit_cast(float, w & 0xffff0000u); }

__device__ __forceinline__ void conv_patch(const bf16_t* __restrict__ Bs, const bf16_t* __restrict__ Ub, const float* __restrict__ taps, bf16_t* __restrict__ G, int pm) {
    int tid_ = threadIdx.x; asm volatile("" : "+v"(tid_));
    if (pm & 15) {
        const int r = tid_ >> 8, c4 = (tid_ & 255) * 4; const size_t t = (size_t)pm * 256 + r;
        const uint2 b = *(const uint2*)(Bs + (size_t)(pm * 2 + r) * D + c4);
        const uint2 x0 = *(const uint2*)(Ub + t * pg8::UPITCH + c4), x1 = *(const uint2*)(Ub + (t - 1) * pg8::UPITCH + c4), x2 = *(const uint2*)(Ub + (t - 2) * pg8::UPITCH + c4);
        const f32x4 w0 = *(const f32x4*)(taps + c4), w1 = *(const f32x4*)(taps + D + c4), w2 = *(const f32x4*)(taps + 2 * D + c4);
        const f32x4 u0 = {bf_lo(x0.x), bf_hi(x0.x), bf_lo(x0.y), bf_hi(x0.y)}, u1 = {bf_lo(x1.x), bf_hi(x1.x), bf_lo(x1.y), bf_hi(x1.y)}, u2 = {bf_lo(x2.x), bf_hi(x2.x), bf_lo(x2.y), bf_hi(x2.y)};
        const f32x4 bv = {bf_lo(b.x), bf_hi(b.x), bf_lo(b.y), bf_hi(b.y)};
        const f32x4 g = ((w0 * u2 + w1 * u1) + w2 * u0) * bv;
        uint2 o; o.x = cvt_pk_bf16(g[0], g[1]); o.y = cvt_pk_bf16(g[2], g[3]);
        *(uint2*)(G + t * D + c4) = o;
    }
    asm volatile("s_waitcnt vmcnt(0)" ::: "memory");
    __syncthreads();
}

__global__ void __launch_bounds__(512, 2) fwd_megakernel(Args a) {
    extern __shared__ __attribute__((aligned(16))) unsigned char lds_raw[];
    LAS unsigned char* lds = (LAS unsigned char*)lds_raw;
    cg::grid_group grid = cg::this_grid();
    if (threadIdx.x < 2) ((volatile LAS unsigned*)(lds + LDS_MISC))[threadIdx.x] = 0u;
    __syncthreads();
    const XcdBarrier xbar = xcd_barrier_post((unsigned*)(a.ws + WS_BAR), (volatile LAS unsigned*)(lds + LDS_MISC));
    const int bid = blockIdx.x, G = gridDim.x;
    unsigned char* ws = a.ws;
    unsigned* cntw = (unsigned*)(ws + WS_CNT);
    float* ystat = (float*)(ws + WS_YSTAT); float* hstat = (float*)(ws + WS_HSTAT);
    bf16_t* Wpool = (bf16_t*)(ws + WS_WPOOL); bf16_t* Wout = (bf16_t*)(ws + WS_WOUT); bf16_t* Win = (bf16_t*)(ws + WS_WIN);
    bf16_t* AN = (bf16_t*)(ws + WS_AN); bf16_t* POOLA = (bf16_t*)(ws + WS_POOLA); bf16_t* ACT = (bf16_t*)(ws + WS_ACT);
    bf16_t* UB = (bf16_t*)(ws + WS_ACT + 32 * MiB); bf16_t* GB = POOLA; bf16_t* BS = (bf16_t*)(ws + WS_BS);

#ifndef NO_P0
#ifndef REP_P0
#define REP_P0 1
#endif
    for (int rep_ = 0; rep_ < REP_P0; ++rep_) {
        float* scr = (float*)lds_raw;
#ifndef REP_PREP
#define REP_PREP 1
#endif
        for (int rp_ = 0; rp_ < REP_PREP; ++rp_)
        for (int ch = bid; ch < M / 64; ch += G) pool_prep_chunk(a.x, a.gains, POOLA, ch, (float*)lds_raw);
        tr_run<0>(a, bid, G, scr);
    }
#endif
    if (a.ws == nullptr) grid.sync();
    xcd_barrier(xbar);

#ifndef NO_POOL
#ifndef REP_POOL
#define REP_POOL 1
#endif
#ifndef REP_SYNC
#define REP_SYNC 0
#endif
    for (int rep_ = 0; rep_ < REP_SYNC; ++rep_) xcd_barrier(xbar);
    for (int rep_ = 0; rep_ < REP_POOL; ++rep_) {
        if (rep_) xcd_barrier(xbar);
        pg8::Gemm g{POOLA, Wpool, 4 * M, 256, 256}; pg8::PoolOrder S{bid};
        pg8::EpiSeam E{a.x, nullptr, nullptr, AN, a.gains + 1 * D, a.pool_scale, ystat, hstat, cntw + 0 * CNT_BANK_WORDS};
        pg8::gemm_phase<pg8::EpiSeam, pg8::PoolOrder, false, true>(lds, g, S, E);
    }
    xcd_barrier(xbar);
#endif

#pragma unroll 1
    for (int l = 0; l < 2; ++l) {
#ifndef NO_L1MIX
        if (l == 1) {
#ifndef REP_INPROJ
#define REP_INPROJ 1
#endif
            for (int rep_ = 0; rep_ < REP_INPROJ; ++rep_) {
                pg8::Gemm g{AN, Win, M, 3 * D, D}; pg8::TripleOrder S{bid};
                pg8::EpiInProj E{GB, UB, BS, a.conv_w, hstat, (LAS float*)(lds + LDS_TAB)};
                pg8::gemm_phase<pg8::EpiInProj, pg8::TripleOrder, true, true>(lds, g, S, E);
            }
            xcd_barrier(xbar);
            {
                pg8::Gemm g{GB, Wout, M, D, D}; pg8::StaticOrder S; S.init(M, D, G, bid);
                { pg8::Unit u0; if (S.next(0, u0)) conv_patch(BS, UB, a.conv_w, GB, u0.pm); }
                pg8::EpiSeam E{nullptr, AN, nullptr, AN, a.gains + 5 * D, nullptr, ystat, hstat, cntw + 1 * CNT_BANK_WORDS};
                pg8::gemm_phase<pg8::EpiSeam, pg8::StaticOrder, false, true>(lds, g, S, E);
            }
            xcd_barrier(xbar);
        }
#endif
#ifndef NO_FFN
#ifndef REP_GU
#define REP_GU 1
#endif
        for (int rep_ = 0; rep_ < REP_GU; ++rep_) {
            pg8::Gemm g{AN, (const bf16_t*)(ws + (l ? WS_WGU1 : WS_WGU0)), M, 2 * FF, D}; pg8::StaticOrder S; S.init(M, 2 * FF, G, bid);
            pg8::EpiSwiGLU E{ACT, hstat, (LAS float*)(lds + LDS_TAB)};
            pg8::gemm_phase<pg8::EpiSwiGLU, pg8::StaticOrder, true, GU_SP2>(lds, g, S, E);
        }
        if (bid >= G / 2) { if (l == 0) tr_run<1>(a, bid - G / 2, G - G / 2, (float*)lds_raw); else tr_run<2>(a, bid - G / 2, G - G / 2, (float*)lds_raw); }
        xcd_barrier(xbar);
        {
            pg8::Gemm g{ACT, (const bf16_t*)(ws + (l ? WS_WDN1 : WS_WDN0)), M, D, FF}; pg8::StaticOrder S; S.init(M, D, G, bid);
            pg8::EpiSeam E{nullptr, AN, l ? a.out : nullptr, l ? nullptr : AN, a.gains + (l * 4 + 3) * D, nullptr, ystat, l ? nullptr : hstat, cntw + (2 + l) * CNT_BANK_WORDS};
            pg8::gemm_phase<pg8::EpiSeam, pg8::StaticOrder, false, true>(lds, g, S, E);
        }
#endif
        if (l == 0) xcd_barrier(xbar);
    }
}

extern "C" void kernel_launch(void* const* d_in, const int* in_sizes, int n_in, void* d_out, int out_size, void* d_ws, size_t ws_size, hipStream_t stream) {
    static int grid = 0;
    if (grid == 0) {
        int dev = 0, cus = 0, per_cu = 0;
        (void)hipGetDevice(&dev);
        (void)hipDeviceGetAttribute(&cus, hipDeviceAttributeMultiprocessorCount, dev);
        (void)hipFuncSetAttribute((const void*)fwd_megakernel, hipFuncAttributeMaxDynamicSharedMemorySize, LDS_BYTES);
        (void)hipOccupancyMaxActiveBlocksPerMultiprocessor(&per_cu, (const void*)fwd_megakernel, 512, LDS_BYTES);
        (void)hipGetLastError();
        if (n_in != 9 || out_size != M * D || ws_size < WS_END || cus * (per_cu > 0 ? per_cu : 1) < 256)
            fprintf(stderr, "kernel_launch: unexpected problem/device: n_in %d out %d ws %zu cus %d per_cu %d\n", n_in, out_size, ws_size, cus, per_cu);
        grid = 256;
    }
    (void)hipMemsetAsync((char*)d_ws + WS_BAR, 0, ZERO_BYTES, stream);
    Args a{};
    a.x = (const float*)d_in[0]; a.gains = (const float*)d_in[1]; a.pool_w = (const float*)d_in[2]; a.pool_scale = (const float*)d_in[3];
    a.conv_in_w = (const float*)d_in[4]; a.conv_w = (const float*)d_in[5]; a.conv_out_w = (const float*)d_in[6]; a.gu_w = (const float*)d_in[7]; a.dn_w = (const float*)d_in[8];
    a.out = (float*)d_out; a.ws = (unsigned char*)d_ws;
    void* args[] = {&a};
    const hipError_t e = hipLaunchCooperativeKernel((const void*)fwd_megakernel, dim3(grid), dim3(512), args, LDS_BYTES, stream);
    if (e != hipSuccess) fprintf(stderr, "cooperative launch failed: %s (grid %d)\n", hipGetErrorString(e), grid);
}
```

```cpp
#include <hip/hip_runtime.h>
#include <hip/hip_cooperative_groups.h>
#include <cstdio>
#include <cstdint>
namespace cg = cooperative_groups;

#define LAS __attribute__((address_space(3)))
#define XB_TMO      128
#define XB_XCNT(j)  (256  + 64 * (j))
#define XB_XSUB(j)  (1280 + 64 * (j))
#define XB_XGEN(j)  (2304 + 64 * (j))
#define XB_TOP      3328
#define XB_TOPGEN   3392
#define XCD_BAR_WORDS 3456
#define XB_SPIN_CAP (1u << 18)

__device__ __forceinline__ unsigned xb_ld(unsigned* p)              { return __hip_atomic_load(p, __ATOMIC_RELAXED, __HIP_MEMORY_SCOPE_AGENT); }
__device__ __forceinline__ unsigned xb_add(unsigned* p, unsigned v) { return __hip_atomic_fetch_add(p, v, __ATOMIC_RELAXED, __HIP_MEMORY_SCOPE_AGENT); }
__device__ __forceinline__ unsigned xb_xcc_id() { return (unsigned)__builtin_amdgcn_s_getreg((3 << 11) | 20) & 0xFu; }
#define XB_SPIN(cond, bar) do { unsigned _sp = 0; while (cond) { __builtin_amdgcn_s_sleep(1); \
    if ((++_sp & 255u) == 0u) { if (xb_ld(&(bar)[XB_TMO])) break; if (_sp > XB_SPIN_CAP) { atomicAdd(&(bar)[XB_TMO], 1u); break; } } } } while (0)

struct XcdBarrier {
    unsigned* bar; unsigned x;
    volatile LAS unsigned* st;
};

__device__ __forceinline__ XcdBarrier xcd_barrier_post(unsigned* bar, volatile LAS unsigned* st) {
    XcdBarrier b; b.bar = bar; b.x = xb_xcc_id(); b.st = st;
    if (threadIdx.x == 0) (void)xb_add(&bar[XB_XCNT(b.x)], 1u);
    return b;
}
__device__ __forceinline__ void xcd_barrier_complete(unsigned* bar, unsigned x, unsigned& nloc, unsigned& nx) {
    const unsigned G = gridDim.x * gridDim.y * gridDim.z;
    unsigned sum, cnt, mine, sp = 0u;
    for (;;) {
        sum = 0u; cnt = 0u; mine = 0u;
#pragma unroll
        for (unsigned j = 0; j < 16; ++j) { const unsigned c = xb_ld(&bar[XB_XCNT(j)]); sum += c; cnt += (c > 0u) ? 1u : 0u; mine = (j == x) ? c : mine; }
        if (sum == G) break;
        __builtin_amdgcn_s_sleep(1);
        if ((++sp & 255u) == 0u) { if (xb_ld(&bar[XB_TMO])) break; if (sp > XB_SPIN_CAP) { atomicAdd(&bar[XB_TMO], 1u); break; } }
    }
    nloc = mine > 0u ? mine : 1u; nx = cnt > 0u ? cnt : 1u;
}

__device__ __forceinline__ void xcd_barrier(const XcdBarrier& b) {
    asm volatile("s_waitcnt vmcnt(0)" ::: "memory");
    __syncthreads();
    if (threadIdx.x == 0) {
        unsigned* bar = b.bar; unsigned bx = b.x; asm volatile("" : "+s"(bx));
        __builtin_amdgcn_s_waitcnt(0);
        unsigned nloc = b.st[0], nx = b.st[1];
        if (nloc == 0u) { xcd_barrier_complete(bar, bx, nloc, nx); b.st[0] = nloc; b.st[1] = nx; }
        const unsigned old = xb_add(&bar[XB_XSUB(bx)], 1u);
        const unsigned gen = old / nloc;
        if (old + 1u == (gen + 1u) * nloc) {
            __builtin_amdgcn_fence(__ATOMIC_RELEASE, "agent");
            asm volatile("s_waitcnt vmcnt(0)" ::: "memory");
            const unsigned og = xb_add(&bar[XB_TOP], 1u);
            const unsigned tg = og / nx;
            if (og + 1u == (tg + 1u) * nx) xb_add(&bar[XB_TOPGEN], 1u);
            else XB_SPIN(xb_ld(&bar[XB_TOPGEN]) == tg, bar);
            __builtin_amdgcn_fence(__ATOMIC_ACQUIRE, "agent");
            xb_add(&bar[XB_XGEN(bx)], 1u);
            asm volatile("s_waitcnt vmcnt(0)" ::: "memory");
        } else {
            XB_SPIN(xb_ld(&bar[XB_XGEN(bx)]) == gen, bar);
            __builtin_amdgcn_fence(__ATOMIC_ACQUIRE, "agent");
            asm volatile("s_waitcnt vmcnt(0)" ::: "memory");
        }
    }
    __syncthreads();
}
#ifndef PG8_WGM
#define PG8_WGM 8
#endif
namespace pg8 {
#define PG8_LAS __attribute__((address_space(3)))
typedef unsigned short bf16_t;
typedef short bf16x8 __attribute__((ext_vector_type(8)));
typedef float f32x4 __attribute__((ext_vector_type(4)));
typedef unsigned u32x4 __attribute__((ext_vector_type(4)));
constexpr int BM = 256, BK = 64, HALF = 128, HTB = HALF * BK * 2  , STAGE_BYTES = 8 * HTB, NXCD = 8, WGM = PG8_WGM;

__host__ __device__ __forceinline__ int lds_byte(int r, int c) { const int st = (r >> 4) * 2 + (c >> 5), rr = r & 15, cc = c & 31, ob = rr * 64 + cc * 2; return st * 1024 + (ob ^ (((ob >> 9) & 1) << 5)); }
__host__ __device__ __forceinline__ void stage_rc(int b, int& R, int& C) { const int st = b / 1024, sb = b % 1024, swz = sb ^ (((sb >> 9) & 1) << 5); R = (st >> 1) * 16 + swz / 64; C = (st & 1) * 32 + (swz % 64) / 2; }
__host__ __device__ __forceinline__ int perm32(int rho) { const int n = rho >> 4, i = rho & 15; return 8 * (i >> 2) + 4 * n + (i & 3); }

struct Unit { int pm, pn; };
struct Gemm { const bf16_t* A; const bf16_t* Bt; int M, N, K; };

struct StaticOrder {
    int nM, nN, nwg, G, c;
    __host__ __device__ void init(int M, int N, int G_, int c_) { nM = M / BM; nN = N / BM; nwg = nM * nN; G = G_; c = c_; }
    __host__ __device__ bool next(int i, Unit& u) const {
        const long L = (long)i * G + c; if (L >= nwg) return false;
        int wgid = (int)L; { const int q = nwg / NXCD, r = nwg % NXCD, xcd = wgid % NXCD, off = wgid / NXCD; wgid = (xcd < r ? xcd * (q + 1) : r * (q + 1) + (xcd - r) * q) + off; }
        const int nig = WGM * nN, gid = wgid / nig, fm = gid * WGM, gsz = (nM - fm) < WGM ? (nM - fm) : WGM;
        u.pm = fm + ((wgid % nig) % gsz); u.pn = (wgid % nig) / gsz; return true;
    }
    __device__ __forceinline__ void a_ready(const Unit&) const {}
    __device__ __forceinline__ void done(const Unit&) const {}
};

__device__ __forceinline__ unsigned cvt_pk_bf16(float lo, float hi) { unsigned r; asm volatile("v_cvt_pk_bf16_f32 %0, %1, %2" : "=v"(r) : "v"(lo), "v"(hi)); return r; }
__device__ __forceinline__ void glds16s(const void* sbase, unsigned voff, unsigned lds_dst) { unsigned keep;
    asm volatile("s_mov_b32 %0, m0\n\ts_mov_b32 m0, %3\n\ts_nop 0\n\tglobal_load_lds_dwordx4 %1, %2\n\ts_mov_b32 m0, %0" : "=&s"(keep) : "v"(voff), "s"(sbase), "s"(lds_dst) : "memory"); }
constexpr int MROWS = 16384, DM = 1024, DFF = 2816;
constexpr float RMS_EPS = 1e-6f;
#ifndef BGRP
#define BGRP 2
#endif
#ifndef UB_PITCH
#define UB_PITCH 1024
#endif
constexpr int UPITCH = UB_PITCH;

__device__ __forceinline__ float rstd_of(const f32x4 p) { return rsqrtf(((p[0] + p[1]) + (p[2] + p[3])) * (1.0f / DM) + RMS_EPS); }
__device__ __forceinline__ float row_rstd4(const float* st, int row) { return rstd_of(*(const f32x4*)(st + (size_t)row * 4)); }
__device__ __forceinline__ unsigned cvt_pk(float lo, float hi) { unsigned r; asm("v_cvt_pk_bf16_f32 %0, %1, %2" : "=v"(r) : "v"(lo), "v"(hi)); return r; }
__device__ __forceinline__ void load_rs8(const float* st, int row0, float (&rs)[2][4]) {
    f32x4 p[2][4];
#pragma unroll
    for (int ai = 0; ai < 2; ++ai)
#pragma unroll
        for (int m = 0; m < 4; ++m) p[ai][m] = *(const f32x4*)(st + (size_t)(row0 + ai * HALF + m * 16) * 4);
#pragma unroll
    for (int ai = 0; ai < 2; ++ai)
#pragma unroll
        for (int m = 0; m < 4; ++m) rs[ai][m] = rstd_of(p[ai][m]);
}

__device__ __forceinline__ void table_rs8(PG8_LAS float* T, const f32x4 st, int tid, int lrow0, float (&rs)[2][4]) {
    if (tid < 256) T[tid] = rstd_of(st);
    asm volatile("s_waitcnt lgkmcnt(0)" ::: "memory"); __builtin_amdgcn_s_barrier(); asm volatile("" ::: "memory");
#pragma unroll
    for (int ai = 0; ai < 2; ++ai)
#pragma unroll
        for (int m = 0; m < 4; ++m) rs[ai][m] = T[lrow0 + ai * HALF + m * 16];
}

__device__ __forceinline__ float lane_xor(float v, int lane, int mask) { return __builtin_bit_cast(float, __builtin_amdgcn_ds_bpermute((lane ^ mask) << 2, __builtin_bit_cast(int, v))); }

struct EpiSwiGLU {
    static constexpr bool PERM = true, AFTER_DRAIN = false;
    bf16_t* O; const float* hstat; PG8_LAS float* T;
    struct Pre { f32x4 st; };
    __device__ __forceinline__ Pre prefetch(const Unit& u, int tid) const { Pre p; p.st = (f32x4){1.f, 1.f, 1.f, 1.f}; if (tid < 256) p.st = *(const f32x4*)((const char*)hstat + (unsigned)(u.pm * BM + tid) * 16u); return p; }
    __device__ __forceinline__ void operator()(const f32x4 (&acc)[2][2][4][2], const Unit& u, int wr, int wc, int fr, int fq, const Pre& pre, int tid) const {
        asm volatile("" : "+v"(fr));
        const int row0 = u.pm * BM + wr * 64 + fr, col0 = u.pn * 128 + wc * 32 + 8 * fq;
        const unsigned vo = (unsigned)(row0 * DFF + col0) * 2u; char* obase = (char*)O;
        float rsv[2][4]; table_rs8(T, pre.st, tid, wr * 64 + fr, rsv);
#pragma unroll
        for (int ai = 0; ai < 2; ++ai)
#pragma unroll
            for (int m = 0; m < 4; ++m) {
                const float rs = rsv[ai][m];
                f32x4 o[2];
#pragma unroll
                for (int n = 0; n < 2; ++n) {
                    const f32x4 g = acc[ai][0][m][n] * rs, up = acc[ai][1][m][n] * rs;
                    f32x4 e = g * (-1.4426950408889634f);
                    e[0] = __builtin_amdgcn_exp2f(e[0]); e[1] = __builtin_amdgcn_exp2f(e[1]); e[2] = __builtin_amdgcn_exp2f(e[2]); e[3] = __builtin_amdgcn_exp2f(e[3]);
                    e = e + 1.0f;
                    e[0] = __builtin_amdgcn_rcpf(e[0]); e[1] = __builtin_amdgcn_rcpf(e[1]); e[2] = __builtin_amdgcn_rcpf(e[2]); e[3] = __builtin_amdgcn_rcpf(e[3]);
                    o[n] = (g * e) * up;
                }
                u32x4 w; w.x = cvt_pk(o[0][0], o[0][1]); w.y = cvt_pk(o[0][2], o[0][3]); w.z = cvt_pk(o[1][0], o[1][1]); w.w = cvt_pk(o[1][2], o[1][3]);
                *(u32x4*)(obase + (vo + (unsigned)((ai * HALF + m * 16) * DFF * 2))) = w;
            }
    }
};

__device__ __forceinline__ float bfl(unsigned w) { return __builtin_bit_cast(float, w << 16); }
__device__ __forceinline__ float bfh(unsigned w) { return __builtin_bit_cast(float, w & 0xffff0000u); }
template <int CTRL> __device__ __forceinline__ u32x4 dpp_row_shr(u32x4 old, u32x4 src) {
    u32x4 r;
#pragma unroll
    for (int c = 0; c < 4; ++c) r[c] = (unsigned)__builtin_amdgcn_update_dpp((int)old[c], (int)src[c], CTRL, 0xf, 0xf, false);
    return r;
}
struct EpiInProj {
    static constexpr bool PERM = true, AFTER_DRAIN = false;
    bf16_t* Gb; bf16_t* Ub; bf16_t* Bs; const float* taps; const float* hstat; PG8_LAS float* T;
    struct Pre { f32x4 st; };
    __device__ __forceinline__ Pre prefetch(const Unit& u, int tid) const { Pre p; p.st = (f32x4){1.f, 1.f, 1.f, 1.f}; if (tid < 256) p.st = *(const f32x4*)((const char*)hstat + (unsigned)(u.pm * BM + tid) * 16u); return p; }
    __device__ __forceinline__ void operator()(const f32x4 (&acc)[2][2][4][2], const Unit& u, int wr, int wc, int fr, int fq, const Pre& pre, int tid) const {
        asm volatile("" : "+v"(fr));
        const int lrow0 = wr * 64 + fr, row0 = u.pm * BM + lrow0;
        float rsv[2][4]; table_rs8(T, pre.st, tid, lrow0, rsv);
        if (u.pn >= 4) {
            const int col0 = (u.pn - 4) * 128 + wc * 32 + 8 * fq;
            const unsigned vo = (unsigned)(row0 * UPITCH + col0) * 2u; char* ub = (char*)Ub;
#pragma unroll
            for (int ai = 0; ai < 2; ++ai)
#pragma unroll
                for (int m = 0; m < 4; ++m) {
                    const float rs = rsv[ai][m];
                    const f32x4 v0 = (acc[ai][0][m][0] * rs) * (acc[ai][1][m][0] * rs), v1 = (acc[ai][0][m][1] * rs) * (acc[ai][1][m][1] * rs);
                    u32x4 w; w.x = cvt_pk(v0[0], v0[1]); w.y = cvt_pk(v0[2], v0[3]); w.z = cvt_pk(v1[0], v1[1]); w.w = cvt_pk(v1[2], v1[3]);
                    *(u32x4*)(ub + (vo + (unsigned)((ai * HALF + m * 16) * UPITCH * 2))) = w;
                }
        } else {
            const bool side = (u.pm & 15) != 0;
            const char* ubase = (const char*)Ub; char* gbase = (char*)Gb;
#pragma unroll
            for (int bj = 0; bj < 2; ++bj) {
                const int cb = u.pn * 256 + bj * HALF + wc * 32 + 8 * fq;
                const unsigned vo = (unsigned)(row0 * DM + cb) * 2u;
                const unsigned vu = (unsigned)(row0 * UPITCH + cb) * 2u;
                const f32x4 w0a = *(const f32x4*)(taps + cb), w0b = *(const f32x4*)(taps + cb + 4), w1a = *(const f32x4*)(taps + DM + cb), w1b = *(const f32x4*)(taps + DM + cb + 4),
                            w2a = *(const f32x4*)(taps + 2 * DM + cb), w2b = *(const f32x4*)(taps + 2 * DM + cb + 4);
#pragma unroll
                for (int ai = 0; ai < 2; ++ai) {
                    u32x4 x0[4], b1, b2;
#pragma unroll
                    for (int m = 0; m < 4; ++m) x0[m] = *(const u32x4*)(ubase + (vu + (unsigned)((ai * HALF + m * 16) * UPITCH * 2)));
                    {
                        const unsigned o = vu + (unsigned)((ai * HALF) * UPITCH * 2);
                        unsigned o1 = (fr == 0) ? o - (unsigned)(UPITCH * 2) : o, o2 = (fr < 2) ? o - (unsigned)(2 * UPITCH * 2) : o;
                        if (ai == 0) { o1 = lrow0 >= 1 ? o1 : o; o2 = lrow0 >= 2 ? o2 : o; }
                        b1 = *(const u32x4*)(ubase + o1); b2 = *(const u32x4*)(ubase + o2);
                    }
#pragma unroll
                    for (int m = 0; m < 4; ++m) {
                        const unsigned o = vo + (unsigned)((ai * HALF + m * 16) * DM * 2);
                        const float rs = rsv[ai][m];
                        const f32x4 ba = acc[ai][bj][m][0] * rs, bb = acc[ai][bj][m][1] * rs;
                        u32x4 x1, x2;
                        if (m == 0) { x1 = dpp_row_shr<0x111>(b1, x0[0]); x2 = dpp_row_shr<0x112>(b2, x0[0]); }
                        else { x1 = dpp_row_shr<0x111>(dpp_row_shr<0x121>(x0[m - 1], x0[m - 1]), x0[m]); x2 = dpp_row_shr<0x112>(dpp_row_shr<0x122>(x0[m - 1], x0[m - 1]), x0[m]); }
                        f32x4 ua, ub_, ga, gb;
                        ua = (f32x4){bfl(x2[0]), bfh(x2[0]), bfl(x2[1]), bfh(x2[1])}; ub_ = (f32x4){bfl(x2[2]), bfh(x2[2]), bfl(x2[3]), bfh(x2[3])};
                        if (ai == 0 && m == 0) { const float k2 = lrow0 >= 2 ? 1.f : 0.f; ua = ua * k2; ub_ = ub_ * k2; }
                        ga = w0a * ua; gb = w0b * ub_;
                        ua = (f32x4){bfl(x1[0]), bfh(x1[0]), bfl(x1[1]), bfh(x1[1])}; ub_ = (f32x4){bfl(x1[2]), bfh(x1[2]), bfl(x1[3]), bfh(x1[3])};
                        if (ai == 0 && m == 0) { const float k1 = lrow0 >= 1 ? 1.f : 0.f; ua = ua * k1; ub_ = ub_ * k1; }
                        ga = ga + w1a * ua; gb = gb + w1b * ub_;
                        ua = (f32x4){bfl(x0[m][0]), bfh(x0[m][0]), bfl(x0[m][1]), bfh(x0[m][1])}; ub_ = (f32x4){bfl(x0[m][2]), bfh(x0[m][2]), bfl(x0[m][3]), bfh(x0[m][3])};
                        ga = (ga + w2a * ua) * ba; gb = (gb + w2b * ub_) * bb;
                        u32x4 w; w.x = cvt_pk(ga[0], ga[1]); w.y = cvt_pk(ga[2], ga[3]); w.z = cvt_pk(gb[0], gb[1]); w.w = cvt_pk(gb[2], gb[3]);
                        *(u32x4*)(gbase + o) = w;
                        if (ai == 0 && m == 0) { if (side && lrow0 < 2) { u32x4 q; q.x = cvt_pk(ba[0], ba[1]); q.y = cvt_pk(ba[2], ba[3]); q.z = cvt_pk(bb[0], bb[1]); q.w = cvt_pk(bb[2], bb[3]);
                            *(u32x4*)(Bs + (size_t)(u.pm * 2 + lrow0) * DM + cb) = q; } }
                    }
                    __builtin_amdgcn_sched_barrier(0);
                }
            }
        }
    }
};
struct TripleOrder {
    int c;
    __device__ bool next(int i, Unit& u) const {
#ifdef PROBE_B4
        if (i > 3 || c >= 256) return false; if (i == 3) i = 2;
#else
        if (i > 2 || c >= 256) return false;
#endif
        const int xcd = c & 7, off = c >> 3, j = off >> 3; u.pm = xcd * 8 + (off & 7);
        u.pn = (i == 2) ? j : 4 + 2 * j + i; return true;
    }
    __device__ __forceinline__ void a_ready(const Unit&) const {}
    __device__ __forceinline__ void done(const Unit&) const {}
};

struct EpiSeam {
    static constexpr bool PERM = true, AFTER_DRAIN = true;
    struct Pre {};
    __device__ __forceinline__ Pre prefetch(const Unit&, int) const { return Pre{}; }
    const float* hin32; const bf16_t* hinb; float* hout32; bf16_t* houtb; const float* gpost; const float* colscale; float* ystat; float* hstat; unsigned* cnt;
    __device__ __forceinline__ void fused(f32x4 (&acc)[2][2][4][2], const Unit& u, int wr, int wc, int fr, int fq, PG8_LAS unsigned char* lds, int wid, int lane) const {
        PG8_LAS float* P = (PG8_LAS float*)lds;
        PG8_LAS float* R = (PG8_LAS float*)(lds + 4096);
        const int tid = wid * 64 + lane;
        const int rowbase = (u.pm & 63) * BM, colbase = u.pn * BM;
        const int lcol = colbase + wc * 32 + 8 * fq;
        uint2 hq[8];
#define SEAM_HQ(ai_, kb_) do { const size_t o_ = (size_t)(rowbase + (ai_) * HALF + wid * 16 + (kb_) * 8) * DM + colbase + 4 * lane; \
            _Pragma("unroll") for (int k = 0; k < 8; ++k) hq[k] = *(const uint2*)(hinb + o_ + (size_t)k * DM); } while (0)
        if (!hin32) SEAM_HQ(0, 0);
        if (colscale) {
#pragma unroll
            for (int bj = 0; bj < 2; ++bj)
#pragma unroll
                for (int n = 0; n < 2; ++n) {
                    const f32x4 sc = *(const f32x4*)(colscale + lcol + bj * HALF + 4 * n);
#pragma unroll
                    for (int ai = 0; ai < 2; ++ai)
#pragma unroll
                        for (int m = 0; m < 4; ++m) acc[ai][bj][m][n] = acc[ai][bj][m][n] * sc;
                }
        }
#pragma unroll
        for (int ai = 0; ai < 2; ++ai)
#pragma unroll
            for (int m = 0; m < 4; ++m) {
                float s = 0.f;
#pragma unroll
                for (int bj = 0; bj < 2; ++bj)
#pragma unroll
                    for (int n = 0; n < 2; ++n) { const f32x4 x = acc[ai][bj][m][n]; s += (x[0] * x[0] + x[1] * x[1]) + (x[2] * x[2] + x[3] * x[3]); }
                s += lane_xor(s, lane, 16); s += lane_xor(s, lane, 32);
                if (fq == 0) P[(ai * HALF + wr * 64 + m * 16 + fr) * 4 + wc] = s;
            }
        __syncthreads();
        f32x4 gp[2][2];
#pragma unroll
        for (int bj = 0; bj < 2; ++bj)
#pragma unroll
            for (int n = 0; n < 2; ++n) gp[bj][n] = *(const f32x4*)(gpost + lcol + bj * HALF + 4 * n);
        constexpr int YP = 260;
        PG8_LAS float* Y = (PG8_LAS float*)(lds + 8192);
#define SEAM_STAGE(ai_) do { _Pragma("unroll") for (int m = 0; m < 4; ++m) { const int lr = wr * 64 + m * 16 + fr; \
            _Pragma("unroll") for (int bj = 0; bj < 2; ++bj) _Pragma("unroll") for (int n = 0; n < 2; ++n) \
                *(PG8_LAS f32x4*)(Y + lr * YP + bj * HALF + wc * 32 + 8 * fq + 4 * n) = acc[ai_][bj][m][n] * gp[bj][n]; } } while (0)
        if (tid < 256) __hip_atomic_store(ystat + (size_t)(rowbase + tid) * 4 + u.pn, (P[tid * 4 + 0] + P[tid * 4 + 1]) + (P[tid * 4 + 2] + P[tid * 4 + 3]), __ATOMIC_RELAXED, __HIP_MEMORY_SCOPE_AGENT);
        asm volatile("s_waitcnt vmcnt(0)" ::: "memory");
        unsigned* pc = cnt + 64 * (u.pm & 63);
        if (lane == 0) __hip_atomic_fetch_add(pc, 1u, __ATOMIC_RELAXED, __HIP_MEMORY_SCOPE_AGENT);
        SEAM_STAGE(0);
        if (wid == 0) {
            unsigned spins = 0;
            while ((unsigned)__builtin_amdgcn_readfirstlane(__hip_atomic_load(pc, __ATOMIC_RELAXED, __HIP_MEMORY_SCOPE_AGENT)) < 32u) { __builtin_amdgcn_s_sleep(1); if (++spins > (1u << 24)) break; }
        }
        asm volatile("s_waitcnt vmcnt(0) lgkmcnt(0)" ::: "memory"); __builtin_amdgcn_s_barrier(); asm volatile("" ::: "memory");
        if (tid < 256) {
            const float* sl = ystat + (size_t)(rowbase + tid) * 4;
            const float t0 = __hip_atomic_load(sl + 0, __ATOMIC_RELAXED, __HIP_MEMORY_SCOPE_AGENT), t1 = __hip_atomic_load(sl + 1, __ATOMIC_RELAXED, __HIP_MEMORY_SCOPE_AGENT),
                        t2 = __hip_atomic_load(sl + 2, __ATOMIC_RELAXED, __HIP_MEMORY_SCOPE_AGENT), t3 = __hip_atomic_load(sl + 3, __ATOMIC_RELAXED, __HIP_MEMORY_SCOPE_AGENT);
            R[tid] = rstd_of((f32x4){t0, t1, t2, t3});
        }
        __syncthreads();
#pragma unroll
        for (int ai = 0; ai < 2; ++ai) {
            if (ai == 1) { SEAM_STAGE(1); __syncthreads(); }
#pragma unroll
            for (int kb = 0; kb < 2; ++kb) {
                f32x4 h[8], y[8]; float rr[8];
                const size_t off0 = (size_t)(rowbase + ai * HALF + wid * 16 + kb * 8) * DM + colbase + 4 * lane;
                if (hin32) {
#pragma unroll
                    for (int k = 0; k < 8; ++k) h[k] = *(const f32x4*)(hin32 + off0 + (size_t)k * DM);
                } else {
#pragma unroll
                    for (int k = 0; k < 8; ++k) h[k] = (f32x4){bfl(hq[k].x), bfh(hq[k].x), bfl(hq[k].y), bfh(hq[k].y)};
                    if (!(ai == 1 && kb == 1)) SEAM_HQ(kb == 0 ? ai : ai + 1, kb == 0 ? 1 : 0);
                }
#pragma unroll
                for (int k = 0; k < 8; ++k) { const int lr = wid * 16 + kb * 8 + k; y[k] = *(const PG8_LAS f32x4*)(Y + lr * YP + 4 * lane); rr[k] = R[ai * HALF + lr]; }
#pragma unroll
                for (int k = 0; k < 8; ++k) h[k] = h[k] + y[k] * rr[k];
                if (hout32) {
#pragma unroll
                    for (int k = 0; k < 8; ++k) *(f32x4*)(hout32 + off0 + (size_t)k * DM) = h[k];
                } else {
#pragma unroll
                    for (int k = 0; k < 8; ++k) { uint2 w; w.x = cvt_pk(h[k][0], h[k][1]); w.y = cvt_pk(h[k][2], h[k][3]); *(uint2*)(houtb + off0 + (size_t)k * DM) = w; }
                }
                if (hstat) {
                    float sq[8];
#pragma unroll
                    for (int k = 0; k < 8; ++k) sq[k] = (h[k][0] * h[k][0] + h[k][1] * h[k][1]) + (h[k][2] * h[k][2] + h[k][3] * h[k][3]);
                    const bool b5 = (lane & 32) != 0, b4 = (lane & 16) != 0, b3 = (lane & 8) != 0;
                    float t4[4], t2[2];
#pragma unroll
                    for (int j = 0; j < 4; ++j) { const float keep = b5 ? sq[j + 4] : sq[j], send = b5 ? sq[j] : sq[j + 4]; t4[j] = keep + lane_xor(send, lane, 32); }
#pragma unroll
                    for (int j = 0; j < 2; ++j) { const float keep = b4 ? t4[j + 2] : t4[j], send = b4 ? t4[j] : t4[j + 2]; t2[j] = keep + lane_xor(send, lane, 16); }
                    float t1 = (b3 ? t2[1] : t2[0]) + lane_xor(b3 ? t2[0] : t2[1], lane, 8);
                    t1 += lane_xor(t1, lane, 4); t1 += lane_xor(t1, lane, 2); t1 += lane_xor(t1, lane, 1);
                    if ((lane & 7) == 0) hstat[(size_t)(rowbase + ai * HALF + wid * 16 + kb * 8 + ((lane >> 5) & 1) * 4 + ((lane >> 4) & 1) * 2 + ((lane >> 3) & 1)) * 4 + u.pn] = t1;
                }
            }
            __syncthreads();
        }
#undef SEAM_STAGE
#undef SEAM_HQ
    }
};

struct PoolOrder {
    int c;
    __device__ bool next(int i, Unit& u) const { if (i > 0 || c >= 256) return false; u.pm = (c & 3) * 64 + (c >> 2); u.pn = c & 3; return true; }
    __device__ __forceinline__ void a_ready(const Unit&) const {}
    __device__ __forceinline__ void done(const Unit&) const {}
};

template <class Epi, class Sched, bool ALIGN_EPI = false, bool SP2 = false>
__device__ __forceinline__ void gemm_phase(PG8_LAS unsigned char* lds, const Gemm g, const Sched& S, const Epi& E) {
    int tid_ = threadIdx.x; asm volatile("" : "+v"(tid_));
    const unsigned lds_u = (unsigned)(size_t)lds;
    const int tid = tid_, wid = __builtin_amdgcn_readfirstlane(tid >> 6), lane = tid & 63, wr = wid >> 2, wc = wid & 3, fr = lane & 15, fq = lane >> 4;
    const int K = g.K, nt = K / BK;
    unsigned voffA[2], voffB[2];
#pragma unroll
    for (int i = 0; i < 2; ++i) { int R, C; stage_rc(tid * 16 + i * 8192, R, C); const int Rb = Epi::PERM ? ((R & ~31) + perm32(R & 31)) : R;
        voffA[i] = (unsigned)(R * K + C) * 2u; voffB[i] = (unsigned)(Rb * K + C) * 2u; }
    const size_t kstep = (size_t)(BK * 2);
    const size_t hstep = (size_t)HALF * K * 2;
    const size_t tstep = 2 * hstep;
    const unsigned ldsw = (unsigned)wid * 1024u;
    const int aoff = lds_byte(wr * 64 + fr, fq * 8), boff = lds_byte(wc * 32 + fr, fq * 8);
#define PG8_SA(b, h) (((b) * 2 + (h)) * HTB)
#define PG8_SB(b, h) ((4 + (b) * 2 + (h)) * HTB)
#define PG8_STAGE(bufoff, gbase, voff) do { _Pragma("unroll") for (int _i = 0; _i < 2; ++_i) \
        glds16s((const void*)(gbase), (voff)[_i], lds_u + (unsigned)(bufoff) + ldsw + (unsigned)(_i * 8192)); } while (0)
#define PG8_LDA(dst, b, h) do { _Pragma("unroll") for (int m = 0; m < 4; ++m) _Pragma("unroll") for (int k = 0; k < 2; ++k) dst[m][k] = *(const PG8_LAS bf16x8*)(lds + PG8_SA(b, h) + aoff + m * 2048 + k * 1024); } while (0)
#define PG8_LDB(dst, b, h) do { _Pragma("unroll") for (int n = 0; n < 2; ++n) _Pragma("unroll") for (int k = 0; k < 2; ++k) dst[n][k] = *(const PG8_LAS bf16x8*)(lds + PG8_SB(b, h) + boff + n * 2048 + k * 1024); } while (0)
#define PG8_MMA(ai, bj, At, Bt) do { __builtin_amdgcn_s_setprio(1); _Pragma("unroll") for (int m = 0; m < 4; ++m) _Pragma("unroll") for (int n = 0; n < 2; ++n) _Pragma("unroll") for (int k = 0; k < 2; ++k) \
        acc[ai][bj][m][n] = __builtin_amdgcn_mfma_f32_16x16x32_bf16(Bt[n][k], At[m][k], acc[ai][bj][m][n], 0, 0, 0); __builtin_amdgcn_s_setprio(0); } while (0)
#define PG8_WAIT_V(n) asm volatile("s_waitcnt vmcnt(" #n ")" ::: "memory")
#define PG8_WAIT_L(n) asm volatile("s_waitcnt lgkmcnt(" #n ")" ::: "memory")
#define PG8_BAR __builtin_amdgcn_s_barrier()
#define PG8_SCHED __builtin_amdgcn_sched_barrier(0)
    Unit cur, nxt; int ui = 0;
    if (!S.next(0, cur)) return;
    f32x4 acc[2][2][4][2];
#pragma unroll
    for (int a = 0; a < 2; ++a)
#pragma unroll
        for (int b = 0; b < 2; ++b)
#pragma unroll
            for (int m = 0; m < 4; ++m)
#pragma unroll
                for (int n = 0; n < 2; ++n) acc[a][b][m][n] = (f32x4){0.f, 0.f, 0.f, 0.f};
    bf16x8 At[4][2], B0[2][2], B1[2][2];
    const char* cA = (const char*)g.A + (size_t)cur.pm * tstep; const char* cB = (const char*)g.Bt + (size_t)cur.pn * tstep;
    S.a_ready(cur);
    typename Epi::Pre pre = E.prefetch(cur, tid);
    if constexpr (SP2) {
        PG8_STAGE(PG8_SB(0, 0), cB, voffB); PG8_STAGE(PG8_SB(0, 1), cB + hstep, voffB); PG8_STAGE(PG8_SA(0, 0), cA, voffA); PG8_STAGE(PG8_SA(0, 1), cA + hstep, voffA);
        if (wr == 1) PG8_BAR;
        PG8_WAIT_V(2); PG8_BAR;
        PG8_STAGE(PG8_SB(1, 0), cB + kstep, voffB); PG8_STAGE(PG8_SA(1, 0), cA + kstep, voffA); PG8_STAGE(PG8_SB(1, 1), cB + hstep + kstep, voffB);
        PG8_WAIT_V(6); PG8_BAR;
    } else {
        PG8_STAGE(PG8_SB(0, 0), cB, voffB); PG8_STAGE(PG8_SA(0, 0), cA, voffA); PG8_STAGE(PG8_SB(0, 1), cB + hstep, voffB); PG8_STAGE(PG8_SA(0, 1), cA + hstep, voffA);
        if (wr == 1) PG8_BAR;
        PG8_WAIT_V(4); PG8_BAR;
        PG8_STAGE(PG8_SB(1, 0), cB + kstep, voffB); PG8_STAGE(PG8_SA(1, 0), cA + kstep, voffA); PG8_STAGE(PG8_SB(1, 1), cB + hstep + kstep, voffB);
        PG8_WAIT_V(6); PG8_BAR;
    }
    for (;;) {
        const bool has_next = S.next(ui + 1, nxt);
        const char* nA = has_next ? (const char*)g.A + (size_t)nxt.pm * tstep : cA; const char* nB = has_next ? (const char*)g.Bt + (size_t)nxt.pn * tstep : cB;
        for (int t = 0; t < nt; t += 2) {
            const bool last = (t == nt - 2);
            const char* a1 = cA + (size_t)(t + 1) * kstep;
            const char* a2 = last ? nA : cA + (size_t)(t + 2) * kstep; const char* b2 = last ? nB : cB + (size_t)(t + 2) * kstep;
            const char* a3 = a2 + kstep; const char* b3 = b2 + kstep;
            if (last && has_next) S.a_ready(nxt);
            if constexpr (SP2) {
            PG8_LDB(B0, 0, 0); PG8_LDB(B1, 0, 1); PG8_SCHED; PG8_LDA(At, 0, 0); PG8_STAGE(PG8_SA(1, 1), a1 + hstep, voffA);
            PG8_WAIT_V(8); PG8_WAIT_L(0); PG8_BAR; PG8_MMA(0, 0, At, B0); PG8_MMA(0, 1, At, B1); PG8_BAR; PG8_SCHED;
            PG8_LDA(At, 0, 1); PG8_STAGE(PG8_SB(0, 0), b2, voffB); PG8_STAGE(PG8_SB(0, 1), b2 + hstep, voffB); PG8_STAGE(PG8_SA(0, 0), a2, voffA);
            PG8_WAIT_V(8); PG8_WAIT_L(0); PG8_BAR; PG8_MMA(1, 0, At, B0); PG8_MMA(1, 1, At, B1); PG8_BAR; PG8_SCHED;
            PG8_LDB(B0, 1, 0); PG8_LDB(B1, 1, 1); PG8_SCHED; PG8_LDA(At, 1, 0); PG8_STAGE(PG8_SA(0, 1), a2 + hstep, voffA);
            PG8_WAIT_V(8); PG8_WAIT_L(0); PG8_BAR; PG8_MMA(0, 0, At, B0); PG8_MMA(0, 1, At, B1); PG8_BAR; PG8_SCHED;
            PG8_LDA(At, 1, 1); PG8_STAGE(PG8_SB(1, 0), b3, voffB); PG8_STAGE(PG8_SB(1, 1), b3 + hstep, voffB); PG8_STAGE(PG8_SA(1, 0), a3, voffA);
            PG8_WAIT_V(8); PG8_WAIT_L(0); PG8_BAR; PG8_MMA(1, 0, At, B0); PG8_MMA(1, 1, At, B1); PG8_BAR; PG8_SCHED;
            } else {
            PG8_LDB(B0, 0, 0); PG8_SCHED; PG8_LDA(At, 0, 0); PG8_STAGE(PG8_SA(1, 1), a1 + hstep, voffA);
            PG8_WAIT_L(8); PG8_BAR; PG8_WAIT_L(0); PG8_MMA(0, 0, At, B0); PG8_BAR; PG8_SCHED;
            PG8_LDB(B1, 0, 1); PG8_STAGE(PG8_SB(0, 0), b2, voffB);
            PG8_BAR; PG8_WAIT_L(0); PG8_MMA(0, 1, At, B1); PG8_BAR;
            PG8_LDA(At, 0, 1); PG8_STAGE(PG8_SA(0, 0), a2, voffA);
            PG8_BAR; PG8_WAIT_L(0); PG8_MMA(1, 0, At, B0); PG8_BAR; PG8_SCHED;
            PG8_STAGE(PG8_SB(0, 1), b2 + hstep, voffB);
            PG8_WAIT_V(6); PG8_BAR; PG8_MMA(1, 1, At, B1); PG8_BAR;
            PG8_LDB(B0, 1, 0); PG8_SCHED; PG8_LDA(At, 1, 0); PG8_STAGE(PG8_SA(0, 1), a2 + hstep, voffA);
            PG8_WAIT_L(8); PG8_BAR; PG8_WAIT_L(0); PG8_MMA(0, 0, At, B0); PG8_BAR; PG8_SCHED;
            PG8_LDB(B1, 1, 1); PG8_STAGE(PG8_SB(1, 0), b3, voffB);
            PG8_BAR; PG8_WAIT_L(0); PG8_MMA(0, 1, At, B1); PG8_BAR;
            PG8_LDA(At, 1, 1); PG8_STAGE(PG8_SA(1, 0), a3, voffA);
            PG8_BAR; PG8_WAIT_L(0); PG8_MMA(1, 0, At, B0); PG8_BAR; PG8_SCHED;
            PG8_STAGE(PG8_SB(1, 1), b3 + hstep, voffB);
            PG8_WAIT_V(6); PG8_BAR; PG8_MMA(1, 1, At, B1); PG8_BAR;
            }
        }
        if constexpr (ALIGN_EPI) { if (wr == 0) PG8_BAR; }
        if constexpr (!Epi::AFTER_DRAIN) { E(acc, cur, wr, wc, fr, fq, pre, tid); S.done(cur); }
        if (!has_next) break;
#pragma unroll
        for (int a = 0; a < 2; ++a)
#pragma unroll
            for (int b = 0; b < 2; ++b)
#pragma unroll
                for (int m = 0; m < 4; ++m)
#pragma unroll
                    for (int n = 0; n < 2; ++n) acc[a][b][m][n] = (f32x4){0.f, 0.f, 0.f, 0.f};
        cur = nxt; cA = nA; cB = nB; ++ui;
        pre = E.prefetch(cur, tid);
        if constexpr (ALIGN_EPI) { if (wr == 1) PG8_BAR; }
    }
    PG8_WAIT_V(0);
    if constexpr (!ALIGN_EPI) { if (wr == 0) PG8_BAR; }
    PG8_BAR;
    if constexpr (Epi::AFTER_DRAIN) { E.fused(acc, cur, wr, wc, fr, fq, lds, wid, lane); S.done(cur); }
#undef PG8_SA
#undef PG8_SB
#undef PG8_STAGE
#undef PG8_LDA
#undef PG8_LDB
#undef PG8_MMA
#undef PG8_WAIT_V
#undef PG8_WAIT_L
#undef PG8_BAR
#undef PG8_SCHED
}
}

using pg8::bf16_t; using pg8::f32x4; using pg8::u32x4; using pg8::cvt_pk_bf16;
constexpr int M = 16384, D = 1024, FF = 2816, SEQ = 4096;
#ifndef TAIL_N
#define TAIL_N 528
#endif
#ifndef POOL_SP2
#define POOL_SP2 true
#endif
#ifndef GU_SP2
#define GU_SP2 true
#endif
constexpr int LDS_BYTES = 147456;
constexpr size_t MiB = 1u << 20;
constexpr size_t WS_BAR = 0, BAR_BYTES = XCD_BAR_WORDS * 4;
constexpr size_t WS_CNT = 16 * 1024, CNT_BANK_WORDS = 64 * 64;
constexpr size_t ZERO_BYTES = 128 * 1024;
constexpr size_t WS_ZEROS = 120 * 1024;
constexpr size_t WS_YSTAT = 128 * 1024, WS_HSTAT = 384 * 1024;
constexpr size_t WS_BS = 640 * 1024;
constexpr int LDS_MISC = 147456 - 1024, LDS_TAB = 147456 - 2048;
constexpr size_t WS_WPOOL = 1 * MiB, WS_WOUT = 2 * MiB, WS_WIN = 4 * MiB, WS_WGU0 = 10 * MiB, WS_WGU1 = 21 * MiB, WS_WDN0 = 32 * MiB, WS_WDN1 = 38 * MiB;
constexpr size_t WS_AN = 44 * MiB;
constexpr size_t WS_POOLA = 76 * MiB;
constexpr size_t WS_ACT = 108 * MiB;
constexpr size_t WS_END = 196 * MiB;

struct Args { const float* x; const float* gains; const float* pool_w; const float* pool_scale; const float* conv_in_w; const float* conv_w; const float* conv_out_w;
              const float* gu_w; const float* dn_w; float* out; unsigned char* ws; };

__device__ __forceinline__ float wave_sum(float v) {
#pragma unroll
    for (int o = 1; o < 64; o <<= 1) v += __shfl_xor(v, o);
    return v;
}

struct TrItem { const float* W; bf16_t* WT; int K, N, kb, nsrc0, ndst0; const float* gain; };
constexpr int I_POOL = 16, I_GU = 352, I_DN = 176, I_IN = 192, I_OUT = 64, NITEMS = I_POOL + 2 * I_GU + 2 * I_DN + I_IN + I_OUT;
template <int SET> __device__ __forceinline__ bool tr_decode(int vi, const Args& a, TrItem& t) {
    int it;
    if (SET == 0) { if (vi >= I_POOL + I_GU) return false; it = vi; }
    else if (SET == 1) { if (vi >= I_DN + I_IN + I_OUT + I_GU) return false;
        it = vi < I_DN ? I_POOL + 2 * I_GU + vi : (vi < I_DN + I_IN + I_OUT ? I_POOL + 2 * I_GU + 2 * I_DN + (vi - I_DN) : I_POOL + I_GU + (vi - I_DN - I_IN - I_OUT)); }
    else { if (vi >= I_DN) return false; it = I_POOL + 2 * I_GU + I_DN + vi; }
    int r = it; unsigned char* ws = a.ws;
    if (r < I_POOL) { const int g = r >> 2, rb = (r >> 1) & 1; t = TrItem{a.pool_w + (size_t)g * 65536, (bf16_t*)(ws + WS_WPOOL) + (size_t)g * 65536, 256, 256, r & 1, 128 * rb, 128 * rb, nullptr}; return true; } r -= I_POOL;
    if (r < 2 * I_GU) { const int l = r / I_GU; r -= l * I_GU; const int rb = r >> 3, pn = rb >> 1, bj = rb & 1;
        t = TrItem{a.gu_w + (size_t)l * D * 2 * FF, (bf16_t*)(ws + (l ? WS_WGU1 : WS_WGU0)), D, 2 * FF, r & 7, bj * FF + 128 * pn, 128 * rb, a.gains + (l * 4 + 2) * D}; return true; } r -= 2 * I_GU;
    if (r < 2 * I_DN) { const int l = r / I_DN; r -= l * I_DN; const int rb = r / 22;
        t = TrItem{a.dn_w + (size_t)l * FF * D, (bf16_t*)(ws + (l ? WS_WDN1 : WS_WDN0)), FF, D, r % 22, 128 * rb, 128 * rb, nullptr}; return true; } r -= 2 * I_DN;
    if (r < I_IN) { const int rb = r >> 3; int ns;
        if (rb < 8) ns = 128 * rb; else { const int q = (rb - 8) >> 1, bj = (rb - 8) & 1; ns = D + bj * D + 128 * q; }
        t = TrItem{a.conv_in_w, (bf16_t*)(ws + WS_WIN), D, 3 * D, r & 7, ns, 128 * rb, a.gains + 4 * D}; return true; } r -= I_IN;
    { const int rb = r >> 3; t = TrItem{a.conv_out_w, (bf16_t*)(ws + WS_WOUT), D, D, r & 7, 128 * rb, 128 * rb, nullptr}; return true; }
}
__device__ __forceinline__ void tr_load(const TrItem& t, f32x4 (&v)[8], int tid) {
    const int lr = tid >> 5, lc = (tid & 31) * 4;
    const float* p = t.W + (size_t)(t.kb * 128 + 2 * lr) * t.N + t.nsrc0 + lc;
#pragma unroll
    for (int i = 0; i < 4; ++i) { v[2 * i] = __builtin_nontemporal_load((const f32x4*)(p + (size_t)(32 * i) * t.N)); v[2 * i + 1] = __builtin_nontemporal_load((const f32x4*)(p + (size_t)(32 * i + 1) * t.N)); }    if (t.gain) {
        const float* gk = t.gain + t.kb * 128 + 2 * lr;
#pragma unroll
        for (int i = 0; i < 4; ++i) { v[2 * i] = v[2 * i] * gk[32 * i]; v[2 * i + 1] = v[2 * i + 1] * gk[32 * i + 1]; }
    }
}
template <int SET> __device__ __forceinline__ void tr_run(const Args& a, int first, int stride, float* scr_) {
    unsigned* scr = (unsigned*)scr_;
    int tid_ = threadIdx.x; asm volatile("" : "+v"(tid_));
    const int tid = tid_, lr = tid >> 5, lc = (tid & 31) * 4;
    const int c = (tid >> 3) & 15, nb = (tid & 7) + 8 * (tid >> 7);
    TrItem cur, nxt; f32x4 v[8];
    int it = first; bool have = tr_decode<SET>(it, a, cur);
    if (have) tr_load(cur, v, tid);
    while (have) {
#pragma unroll
        for (int i = 0; i < 4; ++i) { unsigned* s = scr + (lr + 16 * i) * 129 + lc;
            s[0] = cvt_pk_bf16(v[2 * i][0], v[2 * i + 1][0]); s[1] = cvt_pk_bf16(v[2 * i][1], v[2 * i + 1][1]); s[2] = cvt_pk_bf16(v[2 * i][2], v[2 * i + 1][2]); s[3] = cvt_pk_bf16(v[2 * i][3], v[2 * i + 1][3]); }
        __syncthreads();
        it += stride; const bool hn = tr_decode<SET>(it, a, nxt);
        if (hn) tr_load(nxt, v, tid);
#pragma unroll
        for (int j = 0; j < 4; ++j) {
            const int n = nb + 32 * j; const unsigned* s = scr + (4 * c) * 129 + n;
            u32x4 o; o.x = s[0]; o.y = s[129]; o.z = s[2 * 129]; o.w = s[3 * 129];
            *(u32x4*)(cur.WT + (size_t)(cur.ndst0 + n) * cur.K + cur.kb * 128 + 8 * c) = o;
        }
        __syncthreads();
        cur = nxt; have = hn;
    }
}

__device__ __forceinline__ void pool_prep_chunk(const float* __restrict__ x, const float* __restrict__ g0, bf16_t* __restrict__ poolA, int chunk, float* HN) {
    int tid_ = threadIdx.x; asm volatile("" : "+v"(tid_));
    const int tid = tid_, lane = tid & 63, wave = tid >> 6;
    const int t0 = chunk * 64, p0 = t0 & (SEQ - 1);
    const bool halo = p0 > 0;
    const int cq = tid & 255, hh = tid >> 8, g = cq >> 6, w = 2 << g;
    bf16_t* opb = poolA + ((size_t)g * M + t0) * 256 + ((4 * cq) & 255);
    f32x4 g0v[4];
#pragma unroll
    for (int j = 0; j < 4; ++j) g0v[j] = *(const f32x4*)(g0 + 4 * lane + 256 * j);
    f32x4 rv[2][2][4];
#define PP_ISSUE(blk) do { _Pragma("unroll") for (int q = 0; q < 2; ++q) { const f32x4* xr = (const f32x4*)(x + (size_t)(t0 + 16 * ((blk) - 1) + 2 * wave + q) * D) + lane; \
        _Pragma("unroll") for (int j = 0; j < 4; ++j) rv[(blk) & 1][q][j] = xr[64 * j]; } } while (0)
    if (halo) PP_ISSUE(0);
    else {
#pragma unroll
        for (int q = 0; q < 2; ++q)
#pragma unroll
            for (int j = 0; j < 4; ++j) rv[0][q][j] = (f32x4){0.f, 0.f, 0.f, 0.f};
    }
    PP_ISSUE(1);
#pragma unroll
    for (int b = 0; b < 5; ++b) {
        const int slot = b & 1;
#pragma unroll
        for (int q = 0; q < 2; ++q) {
            float s = 0.f;
#pragma unroll
            for (int j = 0; j < 4; ++j) { const f32x4 v = rv[b & 1][q][j]; s += (v[0] * v[0] + v[1] * v[1]) + (v[2] * v[2] + v[3] * v[3]); }
            s = wave_sum(s);
            const float rs = rsqrtf(s * (1.0f / D) + 1e-6f);
#pragma unroll
            for (int j = 0; j < 4; ++j) *(f32x4*)(HN + (slot * 16 + 2 * wave + q) * 1024 + 4 * lane + 256 * j) = rv[b & 1][q][j] * rs * g0v[j];
        }
        if (b < 3) PP_ISSUE(b + 2);
        __syncthreads();
        if (b >= 1) {
            const float* Xc = HN + slot * 16 * 1024 + 4 * cq; const float* Xp = HN + (slot ^ 1) * 16 * 1024 + 4 * cq;
            const int r0 = 8 * hh, pbase = p0 + 16 * (b - 1) + r0;
#define PP_ROW(r_) (*(const f32x4*)(((r_) < 0 ? Xp : Xc) + ((r_) & 15) * 1024))
            f32x4 s = {0.f, 0.f, 0.f, 0.f};
#pragma unroll
            for (int q = 15; q >= 1; --q) { const float wq = (q < w) ? 1.f : 0.f; s += PP_ROW(r0 - q) * wq; }
#pragma unroll
            for (int i = 0; i < 8; ++i) {
                const int p = pbase + i;
                const f32x4 cur = PP_ROW(r0 + i);
                const f32x4 win = s + cur;
                const float inv = 1.0f / (float)((p + 1 < w) ? p + 1 : w);
                const f32x4 o = win * inv - cur;
                uint2 pk; pk.x = cvt_pk_bf16(o[0], o[1]); pk.y = cvt_pk_bf16(o[2], o[3]);
                *(uint2*)(opb + (size_t)(16 * (b - 1) + r0 + i) * 256) = pk;
                const int ro = r0 + i - w + 1;
                s = win - PP_ROW(ro);
            }
#undef PP_ROW
        }
        __syncthreads();
        __builtin_amdgcn_sched_barrier(0);
    }
#undef PP_ISSUE
}

__device__ __forceinline__ float bf_lo(unsigned w) { return __builtin_bit_cast(float, w << 16); }
__device__ __forceinline__ float bf_hi(unsigned w) { return __builtin_bit_cast(float, w & 0xffff0000u); }

__device__ __forceinline__ void conv_patch(const bf16_t* __restrict__ Bs, const bf16_t* __restrict__ Ub, const float* __restrict__ taps, bf16_t* __restrict__ G, int pm) {
    int tid_ = threadIdx.x; asm volatile("" : "+v"(tid_));
    if (pm & 15) {
        const int r = tid_ >> 8, c4 = (tid_ & 255) * 4; const size_t t = (size_t)pm * 256 + r;
        const uint2 b = *(const uint2*)(Bs + (size_t)(pm * 2 + r) * D + c4);
        const uint2 x0 = *(const uint2*)(Ub + t * pg8::UPITCH + c4), x1 = *(const uint2*)(Ub + (t - 1) * pg8::UPITCH + c4), x2 = *(const uint2*)(Ub + (t - 2) * pg8::UPITCH + c4);
        const f32x4 w0 = *(const f32x4*)(taps + c4), w1 = *(const f32x4*)(taps + D + c4), w2 = *(const f32x4*)(taps + 2 * D + c4);
        const f32x4 u0 = {bf_lo(x0.x), bf_hi(x0.x), bf_lo(x0.y), bf_hi(x0.y)}, u1 = {bf_lo(x1.x), bf_hi(x1.x), bf_lo(x1.y), bf_hi(x1.y)}, u2 = {bf_lo(x2.x), bf_hi(x2.x), bf_lo(x2.y), bf_hi(x2.y)};
        const f32x4 bv = {bf_lo(b.x), bf_hi(b.x), bf_lo(b.y), bf_hi(b.y)};
        const f32x4 g = ((w0 * u2 + w1 * u1) + w2 * u0) * bv;
        uint2 o; o.x = cvt_pk_bf16(g[0], g[1]); o.y = cvt_pk_bf16(g[2], g[3]);
        *(uint2*)(G + t * D + c4) = o;
    }
    asm volatile("s_waitcnt vmcnt(0)" ::: "memory");
    __syncthreads();
}

__global__ void __launch_bounds__(512, 2) fwd_megakernel(Args a) {
    extern __shared__ __attribute__((aligned(16))) unsigned char lds_raw[];
    LAS unsigned char* lds = (LAS unsigned char*)lds_raw;
    cg::grid_group grid = cg::this_grid();
    if (threadIdx.x < 2) ((volatile LAS unsigned*)(lds + LDS_MISC))[threadIdx.x] = 0u;
    __syncthreads();
    const XcdBarrier xbar = xcd_barrier_post((unsigned*)(a.ws + WS_BAR), (volatile LAS unsigned*)(lds + LDS_MISC));
    const int bid = blockIdx.x, G = gridDim.x;
    unsigned char* ws = a.ws;
    unsigned* cntw = (unsigned*)(ws + WS_CNT);
    float* ystat = (float*)(ws + WS_YSTAT); float* hstat = (float*)(ws + WS_HSTAT);
    bf16_t* Wpool = (bf16_t*)(ws + WS_WPOOL); bf16_t* Wout = (bf16_t*)(ws + WS_WOUT); bf16_t* Win = (bf16_t*)(ws + WS_WIN);
    bf16_t* AN = (bf16_t*)(ws + WS_AN); bf16_t* POOLA = (bf16_t*)(ws + WS_POOLA); bf16_t* ACT = (bf16_t*)(ws + WS_ACT);
    bf16_t* UB = (bf16_t*)(ws + WS_ACT + 32 * MiB); bf16_t* GB = POOLA; bf16_t* BS = (bf16_t*)(ws + WS_BS);

#ifndef NO_P0
#ifndef REP_P0
#define REP_P0 1
#endif
    for (int rep_ = 0; rep_ < REP_P0; ++rep_) {
        float* scr = (float*)lds_raw;
#ifndef REP_PREP
#define REP_PREP 1
#endif
        for (int rp_ = 0; rp_ < REP_PREP; ++rp_)
        for (int ch = bid; ch < M / 64; ch += G) pool_prep_chunk(a.x, a.gains, POOLA, ch, (float*)lds_raw);
        tr_run<0>(a, bid, G, scr);
    }
#endif
    if (a.ws == nullptr) grid.sync();
    xcd_barrier(xbar);

#ifndef NO_POOL
#ifndef REP_POOL
#define REP_POOL 1
#endif
#ifndef REP_SYNC
#define REP_SYNC 0
#endif
    for (int rep_ = 0; rep_ < REP_SYNC; ++rep_) xcd_barrier(xbar);
    for (int rep_ = 0; rep_ < REP_POOL; ++rep_) {
        if (rep_) xcd_barrier(xbar);
        pg8::Gemm g{POOLA, Wpool, 4 * M, 256, 256}; pg8::PoolOrder S{bid};
        pg8::EpiSeam E{a.x, nullptr, nullptr, AN, a.gains + 1 * D, a.pool_scale, ystat, hstat, cntw + 0 * CNT_BANK_WORDS};
        pg8::gemm_phase<pg8::EpiSeam, pg8::PoolOrder, false, true>(lds, g, S, E);
    }
    xcd_barrier(xbar);
#endif

#pragma unroll 1
    for (int l = 0; l < 2; ++l) {
#ifndef NO_L1MIX
        if (l == 1) {
#ifndef REP_INPROJ
#define REP_INPROJ 1
#endif
            for (int rep_ = 0; rep_ < REP_INPROJ; ++rep_) {
                pg8::Gemm g{AN, Win, M, 3 * D, D}; pg8::TripleOrder S{bid};
                pg8::EpiInProj E{GB, UB, BS, a.conv_w, hstat, (LAS float*)(lds + LDS_TAB)};
                pg8::gemm_phase<pg8::EpiInProj, pg8::TripleOrder, true, true>(lds, g, S, E);
            }
            xcd_barrier(xbar);
            {
                pg8::Gemm g{GB, Wout, M, D, D}; pg8::StaticOrder S; S.init(M, D, G, bid);
                { pg8::Unit u0; if (S.next(0, u0)) conv_patch(BS, UB, a.conv_w, GB, u0.pm); }
                pg8::EpiSeam E{nullptr, AN, nullptr, AN, a.gains + 5 * D, nullptr, ystat, hstat, cntw + 1 * CNT_BANK_WORDS};
                pg8::gemm_phase<pg8::EpiSeam, pg8::StaticOrder, false, true>(lds, g, S, E);
            }
            xcd_barrier(xbar);
        }
#endif
#ifndef NO_FFN
#ifndef REP_GU
#define REP_GU 1
#endif
        for (int rep_ = 0; rep_ < REP_GU; ++rep_) {
            pg8::Gemm g{AN, (const bf16_t*)(ws + (l ? WS_WGU1 : WS_WGU0)), M, 2 * FF, D}; pg8::StaticOrder S; S.init(M, 2 * FF, G, bid);
            pg8::EpiSwiGLU E{ACT, hstat, (LAS float*)(lds + LDS_TAB)};
            pg8::gemm_phase<pg8::EpiSwiGLU, pg8::StaticOrder, true, GU_SP2>(lds, g, S, E);
        }
        if (bid >= G / 2) { if (l == 0) tr_run<1>(a, bid - G / 2, G - G / 2, (float*)lds_raw); else tr_run<2>(a, bid - G / 2, G - G / 2, (float*)lds_raw); }
        xcd_barrier(xbar);
        {
            pg8::Gemm g{ACT, (const bf16_t*)(ws + (l ? WS_WDN1 : WS_WDN0)), M, D, FF}; pg8::StaticOrder S; S.init(M, D, G, bid);
            pg8::EpiSeam E{nullptr, AN, l ? a.out : nullptr, l ? nullptr : AN, a.gains + (l * 4 + 3) * D, nullptr, ystat, l ? nullptr : hstat, cntw + (2 + l) * CNT_BANK_WORDS};
            pg8::gemm_phase<pg8::EpiSeam, pg8::StaticOrder, false, true>(lds, g, S, E);
        }
#endif
        if (l == 0) xcd_barrier(xbar);
    }
}

extern "C" void kernel_launch(void* const* d_in, const int* in_sizes, int n_in, void* d_out, int out_size, void* d_ws, size_t ws_size, hipStream_t stream) {
    static int grid = 0;
    if (grid == 0) {
        int dev = 0, cus = 0, per_cu = 0;
        (void)hipGetDevice(&dev);
        (void)hipDeviceGetAttribute(&cus, hipDeviceAttributeMultiprocessorCount, dev);
        (void)hipFuncSetAttribute((const void*)fwd_megakernel, hipFuncAttributeMaxDynamicSharedMemorySize, LDS_BYTES);
        (void)hipOccupancyMaxActiveBlocksPerMultiprocessor(&per_cu, (const void*)fwd_megakernel, 512, LDS_BYTES);
        (void)hipGetLastError();
        if (n_in != 9 || out_size != M * D || ws_size < WS_END || cus * (per_cu > 0 ? per_cu : 1) < 256)
            fprintf(stderr, "kernel_launch: unexpected problem/device: n_in %d out %d ws %zu cus %d per_cu %d\n", n_in, out_size, ws_size, cus, per_cu);
        grid = 256;
    }
    (void)hipMemsetAsync((char*)d_ws + WS_BAR, 0, ZERO_BYTES, stream);
    Args a{};
    a.x = (const float*)d_in[0]; a.gains = (const float*)d_in[1]; a.pool_w = (const float*)d_in[2]; a.pool_scale = (const float*)d_in[3];
    a.conv_in_w = (const float*)d_in[4]; a.conv_w = (const float*)d_in[5]; a.conv_out_w = (const float*)d_in[6]; a.gu_w = (const float*)d_in[7]; a.dn_w = (const float*)d_in[8];
    a.out = (float*)d_out; a.ws = (unsigned char*)d_ws;
    void* args[] = {&a};
    const hipError_t e = hipLaunchCooperativeKernel((const void*)fwd_megakernel, dim3(grid), dim3(512), args, LDS_BYTES, stream);
    if (e != hipSuccess) fprintf(stderr, "cooperative launch failed: %s (grid %d)\n", hipGetErrorString(e), grid);
}
```
